# Optimizing an MI355X kernel written in HIP

```python
import math
import jax, jax.numpy as jnp
from jax import lax
import numpy as np

D_MODEL = 1024
BATCH = 2
SEQ = 8192
DEPTH = 1
DEC_BATCH = 8
DEC_SEQ = 4096
PAST_LEN = 128

HEAD_DIM = 64
A_HEADS = 8
A_KV_HEADS = 2
A_GROUP = A_HEADS // A_KV_HEADS
A_Q_W = A_HEADS * HEAD_DIM
A_KV_W = A_KV_HEADS * HEAD_DIM
A_OUT_W = A_Q_W
B_HEADS = 4
B_QK_W = B_HEADS * 2 * HEAD_DIM
B_V_DIM = 2 * HEAD_DIM
B_V_W = B_HEADS * B_V_DIM
IN_W = A_Q_W + 2 * A_KV_W + 2 * B_QK_W + B_V_W
D_FF = 2816
GRID_W = 64
AXIAL_THETA = 10000.0
ROPE_THETA = 500000.0
ROPE_DIM = HEAD_DIM // 4
Q_BLOCK = 128
RMS_EPS = 1e-6
SCALE = 1.0 / math.sqrt(HEAD_DIM)

kernel_name = "hybrid_gqa_axial_diffattn_macaron_encoder"


def rms_norm(x, g):
    xf = x.astype(jnp.float32)
    y = xf * lax.rsqrt(jnp.mean(xf * xf, axis=-1, keepdims=True) + RMS_EPS)
    return (y * g.astype(jnp.float32)).astype(x.dtype)


def swiglu(h, w_gate, w_up, w_down):
    return (jax.nn.silu(h @ w_gate) * (h @ w_up)) @ w_down


def rotate(x, ang):
    m = ang.shape[-1]
    cos = jnp.cos(ang)[:, None, :]
    sin = jnp.sin(ang)[:, None, :]
    xf = x.astype(jnp.float32)
    x1, x2 = xf[..., :m], xf[..., m:]
    return jnp.concatenate([x1 * cos - x2 * sin, x2 * cos + x1 * sin], axis=-1).astype(x.dtype)


def axial_angles(seq_len):
    rows = seq_len // GRID_W
    row = jnp.repeat(jnp.arange(rows, dtype=jnp.float32), GRID_W)
    col = jnp.tile(jnp.arange(GRID_W, dtype=jnp.float32), rows)
    half = HEAD_DIM // 2
    inv = AXIAL_THETA ** (-jnp.arange(0, half, 2, dtype=jnp.float32) / half)
    return jnp.concatenate([row[:, None] * inv, col[:, None] * inv], axis=-1)


def partial_angles(seq_len):
    inv = ROPE_THETA ** (-jnp.arange(0, ROPE_DIM, 2, dtype=jnp.float32) / ROPE_DIM)
    pos = jnp.arange(seq_len, dtype=jnp.float32)
    return pos[:, None] * inv


def gqa_attention(q, k, v):
    bsz, seq_len = q.shape[0], q.shape[1]
    nb = seq_len // Q_BLOCK
    qb = q.reshape(bsz, nb, Q_BLOCK, A_KV_HEADS, A_GROUP, HEAD_DIM).transpose(1, 0, 2, 3, 4, 5)

    def block(qi):
        s = jnp.einsum('bqhgd,bkhd->bhgqk', qi, k).astype(jnp.float32) * SCALE
        p = jax.nn.softmax(s, axis=-1)
        return jnp.einsum('bhgqk,bkhd->bqhgd', p.astype(v.dtype), v)

    o = lax.map(block, qb)
    return o.transpose(1, 0, 2, 3, 4, 5).reshape(bsz, seq_len, A_OUT_W)


def diff_attention(q1, q2, k1, k2, v, lam):
    bsz, seq_len = q1.shape[0], q1.shape[1]
    nb = seq_len // Q_BLOCK

    def to_blocks(t):
        return t.reshape(bsz, nb, Q_BLOCK, B_HEADS, HEAD_DIM).transpose(1, 0, 2, 3, 4)

    def block(qs):
        a, b = qs
        s1 = jnp.einsum('bqhd,bkhd->bhqk', a, k1).astype(jnp.float32) * SCALE
        s2 = jnp.einsum('bqhd,bkhd->bhqk', b, k2).astype(jnp.float32) * SCALE
        p = jax.nn.softmax(s1, axis=-1) - lam * jax.nn.softmax(s2, axis=-1)
        return jnp.einsum('bhqk,bkhe->bqhe', p.astype(v.dtype), v)

    o = lax.map(block, (to_blocks(q1), to_blocks(q2)))
    return o.transpose(1, 0, 2, 3, 4).reshape(bsz, seq_len, B_HEADS, B_V_DIM)


def token_mix(h, w_in, w_branch_gate, a_q_norm, a_k_norm, b_q_norm, b_k_norm,
              b_lambda_q1, b_lambda_k1, b_lambda_q2, b_lambda_k2, b_out_norm,
              w_o_a, w_o_b, w_out, lam_init):
    bsz, seq_len, _ = h.shape
    proj = h @ w_in
    cuts = np.cumsum([A_Q_W, A_KV_W, A_KV_W, B_QK_W, B_QK_W]).tolist()
    qa, ka, va, qb, kb, vb = jnp.split(proj, cuts, axis=-1)

    ang_ax = axial_angles(seq_len)
    qa = rotate(rms_norm(qa.reshape(bsz, seq_len, A_HEADS, HEAD_DIM), a_q_norm), ang_ax)
    ka = rotate(rms_norm(ka.reshape(bsz, seq_len, A_KV_HEADS, HEAD_DIM), a_k_norm), ang_ax)
    va = va.reshape(bsz, seq_len, A_KV_HEADS, HEAD_DIM)
    oa = gqa_attention(qa, ka, va)

    ang_p = partial_angles(seq_len)

    def prep(t, g):
        t = rms_norm(t.reshape(bsz, seq_len, 2 * B_HEADS, HEAD_DIM), g)
        t = jnp.concatenate([rotate(t[..., :ROPE_DIM], ang_p), t[..., ROPE_DIM:]], axis=-1)
        t = t.reshape(bsz, seq_len, B_HEADS, 2, HEAD_DIM)
        return t[..., 0, :], t[..., 1, :]

    q1, q2 = prep(qb, b_q_norm)
    k1, k2 = prep(kb, b_k_norm)
    vb = vb.reshape(bsz, seq_len, B_HEADS, B_V_DIM)
    f32 = jnp.float32
    lam = (jnp.exp(jnp.sum(b_lambda_q1.astype(f32) * b_lambda_k1.astype(f32)))
           - jnp.exp(jnp.sum(b_lambda_q2.astype(f32) * b_lambda_k2.astype(f32))) + lam_init)
    ob = diff_attention(q1, q2, k1, k2, vb, lam)
    ob = (rms_norm(ob, b_out_norm) * (1.0 - lam_init)).reshape(bsz, seq_len, B_V_W)

    ya = oa @ w_o_a
    yb = ob @ w_o_b
    gates = jax.nn.sigmoid(h @ w_branch_gate)
    ga, gb = gates[..., :D_MODEL], gates[..., D_MODEL:]
    return (ga * ya + gb * yb) @ w_out


def run_trunk(x, ffn1_norm, ffn1_w_gate, ffn1_w_up, ffn1_w_down, mix_norm, w_in, w_branch_gate,
              a_q_norm, a_k_norm, b_q_norm, b_k_norm, b_lambda_q1, b_lambda_k1, b_lambda_q2,
              b_lambda_k2, b_out_norm, w_o_a, w_o_b, w_out,
              ffn2_norm, ffn2_w_gate, ffn2_w_up, ffn2_w_down):
    for l in range(DEPTH):
        lam_init = 0.8 - 0.6 * math.exp(-0.3 * l)
        x = x + 0.5 * swiglu(rms_norm(x, ffn1_norm[l]), ffn1_w_gate[l], ffn1_w_up[l], ffn1_w_down[l])
        h = rms_norm(x, mix_norm[l])
        x = x + token_mix(h, w_in[l], w_branch_gate[l], a_q_norm[l], a_k_norm[l], b_q_norm[l],
                          b_k_norm[l], b_lambda_q1[l], b_lambda_k1[l], b_lambda_q2[l],
                          b_lambda_k2[l], b_out_norm[l], w_o_a[l], w_o_b[l], w_out[l], lam_init)
        x = x + 0.5 * swiglu(rms_norm(x, ffn2_norm[l]), ffn2_w_gate[l], ffn2_w_up[l], ffn2_w_down[l])
    return x


def setup_inputs(seed: int = 0) -> dict:
    key = jax.random.key(seed)
    ks = jax.random.split(key, 32)
    f32 = jnp.float32

    def w(k, fan_in, fan_out):
        return jax.random.normal(k, (DEPTH, fan_in, fan_out), f32) * fan_in ** -0.5

    def gain(k, n):
        return 1.0 + 0.02 * jax.random.normal(k, (DEPTH, n), f32)

    def small(k, n):
        return 0.1 * jax.random.normal(k, (DEPTH, n), f32)

    return {
        "x_prompt": jax.random.normal(ks[0], (BATCH, SEQ, D_MODEL), f32),
        "x_sample": jax.random.normal(ks[1], (DEC_BATCH, DEC_SEQ, D_MODEL), f32),
        "ffn1_norm": gain(ks[2], D_MODEL),
        "ffn1_w_gate": w(ks[3], D_MODEL, D_FF),
        "ffn1_w_up": w(ks[4], D_MODEL, D_FF),
        "ffn1_w_down": w(ks[5], D_FF, D_MODEL),
        "mix_norm": gain(ks[6], D_MODEL),
        "w_in": w(ks[7], D_MODEL, IN_W),
        "w_branch_gate": w(ks[8], D_MODEL, 2 * D_MODEL),
        "a_q_norm": gain(ks[9], HEAD_DIM),
        "a_k_norm": gain(ks[10], HEAD_DIM),
        "b_q_norm": gain(ks[11], HEAD_DIM),
        "b_k_norm": gain(ks[12], HEAD_DIM),
        "b_lambda_q1": small(ks[13], HEAD_DIM),
        "b_lambda_k1": small(ks[14], HEAD_DIM),
        "b_lambda_q2": small(ks[15], HEAD_DIM),
        "b_lambda_k2": small(ks[16], HEAD_DIM),
        "b_out_norm": gain(ks[17], B_V_DIM),
        "w_o_a": w(ks[18], A_OUT_W, D_MODEL),
        "w_o_b": w(ks[19], B_V_W, D_MODEL),
        "w_out": w(ks[20], D_MODEL, D_MODEL),
        "ffn2_norm": gain(ks[21], D_MODEL),
        "ffn2_w_gate": w(ks[22], D_MODEL, D_FF),
        "ffn2_w_up": w(ks[23], D_MODEL, D_FF),
        "ffn2_w_down": w(ks[24], D_FF, D_MODEL),
    }


def reference(x_prompt, x_sample, ffn1_norm, ffn1_w_gate, ffn1_w_up, ffn1_w_down, mix_norm, w_in,
              w_branch_gate, a_q_norm, a_k_norm, b_q_norm, b_k_norm, b_lambda_q1, b_lambda_k1,
              b_lambda_q2, b_lambda_k2, b_out_norm, w_o_a, w_o_b, w_out,
              ffn2_norm, ffn2_w_gate, ffn2_w_up, ffn2_w_down):
    y_prompt = run_trunk(x_prompt, ffn1_norm, ffn1_w_gate, ffn1_w_up, ffn1_w_down, mix_norm, w_in,
                         w_branch_gate, a_q_norm, a_k_norm, b_q_norm, b_k_norm, b_lambda_q1,
                         b_lambda_k1, b_lambda_q2, b_lambda_k2, b_out_norm, w_o_a, w_o_b, w_out,
                         ffn2_norm, ffn2_w_gate, ffn2_w_up, ffn2_w_down)
    y_sample = run_trunk(x_sample, ffn1_norm, ffn1_w_gate, ffn1_w_up, ffn1_w_down, mix_norm, w_in,
                         w_branch_gate, a_q_norm, a_k_norm, b_q_norm, b_k_norm, b_lambda_q1,
                         b_lambda_k1, b_lambda_q2, b_lambda_k2, b_out_norm, w_o_a, w_o_b, w_out,
                         ffn2_norm, ffn2_w_gate, ffn2_w_up, ffn2_w_down)
    return (y_prompt, y_sample)
```

```cpp
#include <hip/hip_runtime.h>
#include <hip/hip_cooperative_groups.h>
#include <hip/hip_bf16.h>
#include <cstdio>
#include <cstdint>
#include <cmath>
namespace cg = cooperative_groups;

constexpr int DM = 1024, DFF = 2816;
constexpr int M_P = 2 * 8192, M_S = 8 * 4096, MROWS = M_P + M_S;
constexpr int QOP = 1024;
constexpr int KVP = 1280;
constexpr float RMS_EPS = 1e-6f;
constexpr float LAM_INIT = 0.2f;

namespace pg8 {
#define PG8_LAS __attribute__((address_space(3)))
typedef unsigned short bf16_t;
typedef short bf16x8 __attribute__((ext_vector_type(8)));
typedef float f32x4 __attribute__((ext_vector_type(4)));
typedef unsigned u32x4 __attribute__((ext_vector_type(4)));
typedef unsigned u32x2 __attribute__((ext_vector_type(2)));
constexpr int BM = 256, BK = 64, HALF = 128, HTB = HALF * BK * 2, STAGE_BYTES = 8 * HTB, NXCD = 8, WGM = 8;

__host__ __device__ __forceinline__ int lds_byte(int r, int c) { const int st = (r >> 4) * 2 + (c >> 5), rr = r & 15, cc = c & 31, ob = rr * 64 + cc * 2; return st * 1024 + (ob ^ (((ob >> 9) & 1) << 5)); }
__host__ __device__ __forceinline__ void stage_rc(int b, int& R, int& C) { const int st = b / 1024, sb = b % 1024, swz = sb ^ (((sb >> 9) & 1) << 5); R = (st >> 1) * 16 + swz / 64; C = (st & 1) * 32 + (swz % 64) / 2; }
__host__ __device__ __forceinline__ int perm32(int rho) { const int n = rho >> 4, i = rho & 15; return 8 * (i >> 2) + 4 * n + (i & 3); }

struct Unit { int pm, pn; };
struct Gemm { const bf16_t* A; const bf16_t* Bt; int M, N, K, lda; };

struct StaticOrder {
    int nM, nN, nwg, G, c;
    __host__ __device__ void init(int M, int N, int G_, int c_) { nM = M / BM; nN = N / BM; nwg = nM * nN; G = G_; c = c_; }
    __host__ __device__ bool next(int i, Unit& u) const {
        const long L = (long)i * G + c; if (L >= nwg) return false;
        int wgid = (int)L; { const int q = nwg / NXCD, r = nwg % NXCD, xcd = wgid % NXCD, off = wgid / NXCD; wgid = (xcd < r ? xcd * (q + 1) : r * (q + 1) + (xcd - r) * q) + off; }
        const int nig = WGM * nN, gid = wgid / nig, fm = gid * WGM, gsz = (nM - fm) < WGM ? (nM - fm) : WGM;
        u.pm = fm + ((wgid % nig) % gsz); u.pn = (wgid % nig) / gsz; return true;
    }
};

__device__ __forceinline__ unsigned cvt_pk_bf16(float lo, float hi) { unsigned r; asm volatile("v_cvt_pk_bf16_f32 %0, %1, %2" : "=v"(r) : "v"(lo), "v"(hi)); return r; }
__device__ __forceinline__ float bf_lo(unsigned w) { return __uint_as_float(w << 16); }
__device__ __forceinline__ float bf_hi(unsigned w) { return __uint_as_float(w & 0xffff0000u); }
__device__ __forceinline__ float sigmoidf_(float v) { return __builtin_amdgcn_rcpf(1.0f + __builtin_amdgcn_exp2f(-1.4426950408889634f * v)); }
__device__ __forceinline__ float rstd_of(const float* ssq, int row) {
    const f32x4* p = (const f32x4*)ssq + row; const f32x4 s = (p[0] + p[MROWS]) + (p[2 * MROWS] + p[3 * MROWS]);
    return 1.0f / sqrtf(((s[0] + s[1]) + (s[2] + s[3])) * (1.0f / 1024.0f) + RMS_EPS); }


struct EpiSwiGLU {
    bf16_t* H; const float* ssq;
    __device__ __forceinline__ void operator()(const f32x4 (&acc)[2][2][4][2], const Unit& u, int wr, int wc, int fr, int fq) const {
        const int row0 = u.pm * BM + wr * 64 + fr, colh = u.pn * 128 + wc * 32 + 8 * fq;
#pragma unroll
        for (int ai = 0; ai < 2; ++ai)
#pragma unroll
            for (int m = 0; m < 4; ++m) {
                const int row = row0 + ai * HALF + m * 16;
                const float rs = ssq ? rstd_of(ssq, row) : 1.0f;
                float h[8];
#pragma unroll
                for (int n = 0; n < 2; ++n)
#pragma unroll
                    for (int e = 0; e < 4; ++e) { const float g = acc[ai][0][m][n][e] * rs, uu = acc[ai][1][m][n][e] * rs; h[n * 4 + e] = g * sigmoidf_(g) * uu; }
                u32x4 w; w.x = cvt_pk_bf16(h[0], h[1]); w.y = cvt_pk_bf16(h[2], h[3]); w.z = cvt_pk_bf16(h[4], h[5]); w.w = cvt_pk_bf16(h[6], h[7]);
                *(u32x4*)(H + (size_t)row * DFF + colh) = w;
            }
    }
};
template <int ALPHA2  , bool WX> struct EpiRes {
    const float* xin_p; const float* xin_s; float* out; bf16_t* xn; const float* gn; float* ssq;
    __device__ __forceinline__ void operator()(const f32x4 (&acc)[2][2][4][2], const Unit& u, int wr, int wc, int fr, int fq) const {
        const int row0 = u.pm * BM + wr * 64 + fr, col0 = u.pn * BM + wc * 32 + 8 * fq;
        f32x4 gv[2][2];
        if constexpr (WX) {
#pragma unroll
            for (int bj = 0; bj < 2; ++bj)
#pragma unroll
                for (int n = 0; n < 2; ++n) gv[bj][n] = *(const f32x4*)(gn + col0 + bj * HALF + 4 * n);
        }
#pragma unroll
        for (int ai = 0; ai < 2; ++ai)
#pragma unroll
            for (int m = 0; m < 4; ++m) {
                const int row = row0 + ai * HALF + m * 16;
                const float* xr = (row < M_P) ? xin_p + (size_t)row * DM : xin_s + (size_t)(row - M_P) * DM;
                float* orow = out + (size_t)row * DM;
                float ss = 0.f;
#pragma unroll
                for (int bj = 0; bj < 2; ++bj) {
                    f32x4 o[2];
#pragma unroll
                    for (int n = 0; n < 2; ++n) { const f32x4 xv = *(const f32x4*)(xr + col0 + bj * HALF + 4 * n); o[n] = xv + acc[ai][bj][m][n] * (0.5f * ALPHA2); *(f32x4*)(orow + col0 + bj * HALF + 4 * n) = o[n]; }
                    if constexpr (WX) {
#pragma unroll
                        for (int n = 0; n < 2; ++n) ss += (o[n][0] * o[n][0] + o[n][1] * o[n][1]) + (o[n][2] * o[n][2] + o[n][3] * o[n][3]);
                        const f32x4 a = o[0] * gv[bj][0], b = o[1] * gv[bj][1];
                        u32x4 w; w.x = cvt_pk_bf16(a[0], a[1]); w.y = cvt_pk_bf16(a[2], a[3]); w.z = cvt_pk_bf16(b[0], b[1]); w.w = cvt_pk_bf16(b[2], b[3]);
                        *(u32x4*)(xn + (size_t)row * DM + col0 + bj * HALF) = w;
                    }
                }
                if constexpr (WX) { ss += __shfl_xor(ss, 16); ss += __shfl_xor(ss, 32); if (fq == 0) ssq[((size_t)u.pn * MROWS + row) * 4 + wc] = ss; }
            }
    }
};
struct EpiInProjPrep {
    bf16_t* QO; bf16_t* KV; const float* ssq; const float* rope; const float* gaq; const float* gak; const float* gbq; const float* gbk;
    __device__ __forceinline__ void operator()(const f32x4 (&acc)[2][2][4][2], const Unit& u, int wr, int wc, int fr, int fq) const {
        const int row0 = u.pm * BM + wr * 64 + fr;
        int type; const float* gain; bf16_t* base; int pitch; float scale = 1.0f;
        if (u.pn < 4) { base = QO + u.pn * BM + wc * 64; pitch = QOP; scale = 0.125f * 1.4426950408889634f; if (u.pn < 2) { type = 1; gain = gaq; } else { type = 2; gain = gbq; } }
        else { base = KV + (u.pn - 4) * BM + wc * 64; pitch = KVP; gain = gbk;
               if (u.pn == 4) { type = (wc < 2) ? 1 : 0; gain = gak; } else if (u.pn < 7) { type = 2; } else { type = 0; } }
        base += 8 * fq;
        f32x4 g[4];
#pragma unroll
        for (int q = 0; q < 4; ++q) g[q] = *(const f32x4*)(gain + (q >> 1) * 32 + 8 * fq + (q & 1) * 4);
#pragma unroll
        for (int ai = 0; ai < 2; ++ai)
#pragma unroll
            for (int m = 0; m < 4; ++m) {
                const int row = row0 + ai * HALF + m * 16;
                const float rs = rstd_of(ssq, row);
                float lo[8], hi[8];
#pragma unroll
                for (int n = 0; n < 2; ++n)
#pragma unroll
                    for (int e = 0; e < 4; ++e) { lo[4 * n + e] = acc[ai][0][m][n][e] * rs; hi[4 * n + e] = acc[ai][1][m][n][e] * rs; }
                if (type != 0) {
                    float ss = 0.f;
#pragma unroll
                    for (int k = 0; k < 8; ++k) ss += lo[k] * lo[k] + hi[k] * hi[k];
                    ss += __shfl_xor(ss, 16); ss += __shfl_xor(ss, 32);
                    const float rn = 1.0f / sqrtf(ss * (1.0f / 64.0f) + RMS_EPS);
#pragma unroll
                    for (int k = 0; k < 8; ++k) { lo[k] *= rn * g[k >> 2][k & 3]; hi[k] *= rn * g[2 + (k >> 2)][k & 3]; }
                    const int t = (row < M_P) ? (row & 8191) : ((row - M_P) & 4095);
                    const f32x4* rp = (const f32x4*)(rope + ((size_t)t * 40 + (type == 1 ? 8 * fq : 32)) * 2);
                    const f32x4 c01 = rp[0], c23 = rp[1], c45 = rp[2], c67 = rp[3];
                    const float cs[16] = {c01[0], c01[1], c01[2], c01[3], c23[0], c23[1], c23[2], c23[3], c45[0], c45[1], c45[2], c45[3], c67[0], c67[1], c67[2], c67[3]};
                    if (type == 1) {
#pragma unroll
                        for (int k = 0; k < 8; ++k) { const float a = lo[k], b = hi[k]; lo[k] = a * cs[2 * k] - b * cs[2 * k + 1]; hi[k] = b * cs[2 * k] + a * cs[2 * k + 1]; }
                    } else {
#pragma unroll
                        for (int k = 0; k < 8; ++k) { const float p = __shfl_xor(lo[k], 16); const float r = (fq == 0) ? lo[k] * cs[2 * k] - p * cs[2 * k + 1] : lo[k] * cs[2 * k] + p * cs[2 * k + 1]; lo[k] = (fq < 2) ? r : lo[k]; }
                    }
#pragma unroll
                    for (int k = 0; k < 8; ++k) { lo[k] *= scale; hi[k] *= scale; }
                }
                u32x4 w0, w1;
                w0.x = cvt_pk_bf16(lo[0], lo[1]); w0.y = cvt_pk_bf16(lo[2], lo[3]); w0.z = cvt_pk_bf16(lo[4], lo[5]); w0.w = cvt_pk_bf16(lo[6], lo[7]);
                w1.x = cvt_pk_bf16(hi[0], hi[1]); w1.y = cvt_pk_bf16(hi[2], hi[3]); w1.z = cvt_pk_bf16(hi[4], hi[5]); w1.w = cvt_pk_bf16(hi[6], hi[7]);
                *(u32x4*)(base + (size_t)row * pitch) = w0; *(u32x4*)(base + (size_t)row * pitch + 32) = w1;
            }
    }
};
struct EpiGate {
    bf16_t* G; const float* ssq;
    __device__ __forceinline__ void operator()(const f32x4 (&acc)[2][2][4][2], const Unit& u, int wr, int wc, int fr, int fq) const {
        const int row0 = u.pm * BM + wr * 64 + fr;
        bf16_t* base = G + u.pn * BM + wc * 32 + 8 * fq;
#pragma unroll
        for (int ai = 0; ai < 2; ++ai)
#pragma unroll
            for (int m = 0; m < 4; ++m) {
                const int row = row0 + ai * HALF + m * 16;
                const float rs = rstd_of(ssq, row);
#pragma unroll
                for (int bj = 0; bj < 2; ++bj) {
                    float v[8];
#pragma unroll
                    for (int n = 0; n < 2; ++n)
#pragma unroll
                        for (int e = 0; e < 4; ++e) v[n * 4 + e] = acc[ai][bj][m][n][e] * rs;
                    u32x4 w; w.x = cvt_pk_bf16(v[0], v[1]); w.y = cvt_pk_bf16(v[2], v[3]); w.z = cvt_pk_bf16(v[4], v[5]); w.w = cvt_pk_bf16(v[6], v[7]);
                    *(u32x4*)(base + (size_t)row * 2048 + bj * HALF) = w;
                }
            }
    }
};
struct EpiMerge {
    const bf16_t* G; bf16_t* T;
    __device__ __forceinline__ void operator()(const f32x4 (&acc)[2][2][4][2], const Unit& u, int wr, int wc, int fr, int fq) const {
        const int row0 = u.pm * BM + wr * 64 + fr;
        const bf16_t* gb_ = G + u.pn * BM + wc * 32 + 8 * fq;
        bf16_t* tb = T + u.pn * 128 + wc * 32 + 8 * fq;
#pragma unroll
        for (int ai = 0; ai < 2; ++ai)
#pragma unroll
            for (int m = 0; m < 4; ++m) {
                const int row = row0 + ai * HALF + m * 16;
                const u32x4 ga = *(const u32x4*)(gb_ + (size_t)row * 2048), gb = *(const u32x4*)(gb_ + (size_t)row * 2048 + HALF);
                const f32x4 a0 = acc[ai][0][m][0], a1 = acc[ai][0][m][1], b0 = acc[ai][1][m][0], b1 = acc[ai][1][m][1];
                float t[8];
                t[0] = sigmoidf_(bf_lo(ga.x)) * a0[0] + sigmoidf_(bf_lo(gb.x)) * b0[0]; t[1] = sigmoidf_(bf_hi(ga.x)) * a0[1] + sigmoidf_(bf_hi(gb.x)) * b0[1];
                t[2] = sigmoidf_(bf_lo(ga.y)) * a0[2] + sigmoidf_(bf_lo(gb.y)) * b0[2]; t[3] = sigmoidf_(bf_hi(ga.y)) * a0[3] + sigmoidf_(bf_hi(gb.y)) * b0[3];
                t[4] = sigmoidf_(bf_lo(ga.z)) * a1[0] + sigmoidf_(bf_lo(gb.z)) * b1[0]; t[5] = sigmoidf_(bf_hi(ga.z)) * a1[1] + sigmoidf_(bf_hi(gb.z)) * b1[1];
                t[6] = sigmoidf_(bf_lo(ga.w)) * a1[2] + sigmoidf_(bf_lo(gb.w)) * b1[2]; t[7] = sigmoidf_(bf_hi(ga.w)) * a1[3] + sigmoidf_(bf_hi(gb.w)) * b1[3];
                u32x4 w; w.x = cvt_pk_bf16(t[0], t[1]); w.y = cvt_pk_bf16(t[2], t[3]); w.z = cvt_pk_bf16(t[4], t[5]); w.w = cvt_pk_bf16(t[6], t[7]);
                *(u32x4*)(tb + (size_t)row * DM) = w;
            }
    }
};

template <class Epi, bool ALIGN_EPI = true, bool BLOCKDIAG = false>
__device__ __forceinline__ void gemm_phase(PG8_LAS unsigned char* lds, const Gemm g, const StaticOrder& S, const Epi& E) {
    int tid_ = threadIdx.x; asm volatile("" : "+v"(tid_));
    const int tid = tid_, wid = __builtin_amdgcn_readfirstlane(tid >> 6), lane = tid & 63, wr = wid >> 2, wc = wid & 3, fr = lane & 15, fq = lane >> 4;
    const int K = g.K, nt = K / BK;
    unsigned voffA[2], voffB[2];
#pragma unroll
    for (int i = 0; i < 2; ++i) { int R, C; stage_rc(tid * 16 + i * 8192, R, C); const int Rb = (R & ~31) + perm32(R & 31);
        voffA[i] = (unsigned)(R * g.lda + C) * 2u; voffB[i] = (unsigned)(Rb * K + C) * 2u; }
    const size_t kstep = (size_t)(BK * 2);
    const size_t hstepA = (size_t)HALF * g.lda * 2, tstepA = 2 * hstepA;
    const size_t hstepB = (size_t)HALF * K * 2, tstepB = 2 * hstepB;
    const unsigned ldsw = (unsigned)wid * 1024u;
    const int aoff = lds_byte(wr * 64 + fr, fq * 8), boff = lds_byte(wc * 32 + fr, fq * 8);
#define PG8_SA(b, h) (((b) * 2 + (h)) * HTB)
#define PG8_SB(b, h) ((4 + (b) * 2 + (h)) * HTB)
#define PG8_STAGE(bufoff, gbase, voff) do { _Pragma("unroll") for (int _i = 0; _i < 2; ++_i) \
        __builtin_amdgcn_global_load_lds((const unsigned*)((const char*)(gbase) + (voff)[_i]), (PG8_LAS unsigned*)(lds + (bufoff) + ldsw + _i * 8192), 16, 0, 0); } while (0)
#define PG8_LDA(dst, b, h) do { _Pragma("unroll") for (int m = 0; m < 4; ++m) _Pragma("unroll") for (int k = 0; k < 2; ++k) dst[m][k] = *(const PG8_LAS bf16x8*)(lds + PG8_SA(b, h) + aoff + m * 2048 + k * 1024); } while (0)
#define PG8_LDB(dst, b, h) do { _Pragma("unroll") for (int n = 0; n < 2; ++n) _Pragma("unroll") for (int k = 0; k < 2; ++k) dst[n][k] = *(const PG8_LAS bf16x8*)(lds + PG8_SB(b, h) + boff + n * 2048 + k * 1024); } while (0)
#define PG8_MMA(ai, bj, At, Bt) do { __builtin_amdgcn_s_setprio(1); _Pragma("unroll") for (int m = 0; m < 4; ++m) _Pragma("unroll") for (int n = 0; n < 2; ++n) _Pragma("unroll") for (int k = 0; k < 2; ++k) \
        acc[ai][bj][m][n] = __builtin_amdgcn_mfma_f32_16x16x32_bf16(Bt[n][k], At[m][k], acc[ai][bj][m][n], 0, 0, 0); __builtin_amdgcn_s_setprio(0); } while (0)
#define PG8_WAIT_V(n) asm volatile("s_waitcnt vmcnt(" #n ")" ::: "memory")
#define PG8_WAIT_L(n) asm volatile("s_waitcnt lgkmcnt(" #n ")" ::: "memory")
#define PG8_BAR __builtin_amdgcn_s_barrier()
#define PG8_SCHED __builtin_amdgcn_sched_barrier(0)
#define PG8_MM2(ai, SEL) do { if constexpr ((SEL) != 1) { PG8_MMA(ai, 0, At, B0); } if constexpr ((SEL) != 0) { PG8_MMA(ai, 1, At, B1); } } while (0)
#define PG8_LDB2(b, SEL) do { if constexpr ((SEL) != 1) { PG8_LDB(B0, b, 0); } if constexpr ((SEL) != 0) { PG8_LDB(B1, b, 1); } } while (0)
#define PG8_KLOOP(T0, T1, SEL) for (int t = (T0); t < (T1); t += 2) { \
            const bool last = (t == nt - 2); \
            const char* a1 = cA + (size_t)(t + 1) * kstep; \
            const char* a2 = last ? nA : cA + (size_t)(t + 2) * kstep; const char* b2 = last ? nB : cB + (size_t)(t + 2) * kstep; \
            const char* a3 = a2 + kstep; const char* b3 = b2 + kstep; \
            PG8_LDB2(0, SEL); PG8_SCHED; PG8_LDA(At, 0, 0); PG8_STAGE(PG8_SA(1, 1), a1 + hstepA, voffA); \
            PG8_WAIT_V(8); PG8_WAIT_L(0); PG8_BAR; PG8_MM2(0, SEL); PG8_BAR; PG8_SCHED; \
            PG8_LDA(At, 0, 1); PG8_STAGE(PG8_SB(0, 0), b2, voffB); PG8_STAGE(PG8_SB(0, 1), b2 + hstepB, voffB); PG8_STAGE(PG8_SA(0, 0), a2, voffA); \
            PG8_WAIT_V(8); PG8_WAIT_L(0); PG8_BAR; PG8_MM2(1, SEL); PG8_BAR; PG8_SCHED; \
            PG8_LDB2(1, SEL); PG8_SCHED; PG8_LDA(At, 1, 0); PG8_STAGE(PG8_SA(0, 1), a2 + hstepA, voffA); \
            PG8_WAIT_V(8); PG8_WAIT_L(0); PG8_BAR; PG8_MM2(0, SEL); PG8_BAR; PG8_SCHED; \
            PG8_LDA(At, 1, 1); PG8_STAGE(PG8_SB(1, 0), b3, voffB); PG8_STAGE(PG8_SB(1, 1), b3 + hstepB, voffB); PG8_STAGE(PG8_SA(1, 0), a3, voffA); \
            PG8_WAIT_V(8); PG8_WAIT_L(0); PG8_BAR; PG8_MM2(1, SEL); PG8_BAR; PG8_SCHED; \
 \
        }
    Unit cur, nxt; int ui = 0;
    if (!S.next(0, cur)) return;
    f32x4 acc[2][2][4][2];
#pragma unroll
    for (int a = 0; a < 2; ++a)
#pragma unroll
        for (int b = 0; b < 2; ++b)
#pragma unroll
            for (int m = 0; m < 4; ++m)
#pragma unroll
                for (int n = 0; n < 2; ++n) acc[a][b][m][n] = (f32x4){0.f, 0.f, 0.f, 0.f};
    bf16x8 At[4][2], B0[2][2], B1[2][2];
    const char* cA = (const char*)g.A + (size_t)cur.pm * tstepA; const char* cB = (const char*)g.Bt + (size_t)cur.pn * tstepB;
    PG8_STAGE(PG8_SB(0, 0), cB, voffB); PG8_STAGE(PG8_SB(0, 1), cB + hstepB, voffB); PG8_STAGE(PG8_SA(0, 0), cA, voffA); PG8_STAGE(PG8_SA(0, 1), cA + hstepA, voffA);
    if (wr == 1) PG8_BAR;
    PG8_WAIT_V(2); PG8_BAR;
    PG8_STAGE(PG8_SB(1, 0), cB + kstep, voffB); PG8_STAGE(PG8_SA(1, 0), cA + kstep, voffA); PG8_STAGE(PG8_SB(1, 1), cB + hstepB + kstep, voffB);
    PG8_WAIT_V(6); PG8_BAR;
    for (;;) {
        const bool has_next = S.next(ui + 1, nxt);
        const char* nA = has_next ? (const char*)g.A + (size_t)nxt.pm * tstepA : cA; const char* nB = has_next ? (const char*)g.Bt + (size_t)nxt.pn * tstepB : cB;
        if constexpr (BLOCKDIAG) { PG8_KLOOP(0, nt / 2, 0) PG8_KLOOP(nt / 2, nt, 1) } else { PG8_KLOOP(0, nt, 2) }
        if constexpr (ALIGN_EPI) { if (wr == 0) PG8_BAR; }
        E(acc, cur, wr, wc, fr, fq);
        if (!has_next) break;
#pragma unroll
        for (int a = 0; a < 2; ++a)
#pragma unroll
            for (int b = 0; b < 2; ++b)
#pragma unroll
                for (int m = 0; m < 4; ++m)
#pragma unroll
                    for (int n = 0; n < 2; ++n) acc[a][b][m][n] = (f32x4){0.f, 0.f, 0.f, 0.f};
        cur = nxt; cA = nA; cB = nB; ++ui;
        if constexpr (ALIGN_EPI) { if (wr == 1) PG8_BAR; }
    }
    PG8_WAIT_V(0);
    if constexpr (!ALIGN_EPI) { if (wr == 0) PG8_BAR; }
    PG8_BAR;
#undef PG8_SA
#undef PG8_SB
#undef PG8_STAGE
#undef PG8_LDA
#undef PG8_LDB
#undef PG8_MMA
#undef PG8_WAIT_V
#undef PG8_WAIT_L
#undef PG8_BAR
#undef PG8_SCHED
#undef PG8_MM2
#undef PG8_LDB2
#undef PG8_KLOOP
}
}

namespace attn_body {
using bf16=__hip_bfloat16;
using bf16x8=__attribute__((ext_vector_type(8)))short;
using s16x4=__attribute__((ext_vector_type(4)))short;
using f32x16=__attribute__((ext_vector_type(16)))float;
using u32x4=__attribute__((ext_vector_type(4)))unsigned;
constexpr int D=64;
constexpr int NW=8,QBLK=32,QB=QBLK*NW,KVBLK=64;
__device__ __forceinline__ int crow(int r,int hi){return (r&3)+8*(r>>2)+4*hi;}
#define SBAR() __builtin_amdgcn_sched_barrier(0)
constexpr int NSLOT=3, SLOTB=8192;
constexpr int LDS_K=0, LDS_V=NSLOT*SLOTB, LDS_WS=2*NSLOT*SLOTB, LDS_OST=LDS_WS+NW*64*4, LDS_BYTES=LDS_OST+NW*4096;
constexpr float C2=0.125f*1.4426950408889634f;
__device__ __forceinline__ void glds16(const void*gsrc,unsigned lds_dst){unsigned keep;
  asm volatile("s_mov_b32 %0, m0\n\ts_mov_b32 m0, %2\n\ts_nop 0\n\tglobal_load_lds_dwordx4 %1, off\n\ts_mov_b32 m0, %0":"=&s"(keep):"v"(gsrc),"s"(lds_dst):"memory");}
__device__ __forceinline__ float max3f(float a,float b,float c){float r;asm("v_max3_f32 %0, %1, %2, %3":"=v"(r):"v"(a),"v"(b),"v"(c));return r;}
__device__ __forceinline__ float max2f(float a,float b){float r;asm("v_max_f32_e32 %0, %1, %2":"=v"(r):"v"(a),"v"(b));return r;}
__device__ __forceinline__ float fadd_s(float a,float b){float r;asm("v_add_f32_e32 %0, %1, %2":"=v"(r):"v"(a),"v"(b));return r;}
__device__ __forceinline__ float fsub_s(float a,float b){float r;asm("v_sub_f32_e32 %0, %1, %2":"=v"(r):"v"(a),"v"(b));return r;}
typedef float f32x2_t __attribute__((ext_vector_type(2))); typedef __bf16 bf16x2_t __attribute__((ext_vector_type(2)));
__device__ __forceinline__ unsigned cvtpk_s(float lo,float hi){f32x2_t v={lo,hi};bf16x2_t b=__builtin_convertvector(v,bf16x2_t);return __builtin_bit_cast(unsigned,b);}
#define WAIT_BAR(N) asm volatile("s_waitcnt vmcnt(" #N ") lgkmcnt(0)\n\ts_barrier":::"memory")

__device__ __forceinline__ void qkt(f32x16&p0,f32x16&p1,const char*Kslot,const bf16x8*qr,const f32x16&negm,int r32,int hi){
  const char*kb=Kslot+hi*1024+r32*16;
  #pragma unroll
  for(int d0=0;d0<4;++d0){
    const bf16x8 b0=*reinterpret_cast<const bf16x8*>(kb+d0*2048);
    const bf16x8 b1=*reinterpret_cast<const bf16x8*>(kb+d0*2048+512);
    if(d0==0){p0=__builtin_amdgcn_mfma_f32_32x32x16_bf16(b0,qr[0],negm,0,0,0);p1=__builtin_amdgcn_mfma_f32_32x32x16_bf16(b1,qr[0],negm,0,0,0);}
    else{p0=__builtin_amdgcn_mfma_f32_32x32x16_bf16(b0,qr[d0],p0,0,0,0);p1=__builtin_amdgcn_mfma_f32_32x32x16_bf16(b1,qr[d0],p1,0,0,0);}}
}
typedef __attribute__((address_space(3))) const char* lds_cptr;
typedef short v4i16_t __attribute__((ext_vector_type(4)));
__device__ __forceinline__ void kload8(bf16x8*kf,lds_cptr kp){
  kf[0]=*(const __attribute__((address_space(3))) bf16x8*)(kp);      kf[1]=*(const __attribute__((address_space(3))) bf16x8*)(kp+512);
  kf[2]=*(const __attribute__((address_space(3))) bf16x8*)(kp+2048); kf[3]=*(const __attribute__((address_space(3))) bf16x8*)(kp+2560);
  kf[4]=*(const __attribute__((address_space(3))) bf16x8*)(kp+4096); kf[5]=*(const __attribute__((address_space(3))) bf16x8*)(kp+4608);
  kf[6]=*(const __attribute__((address_space(3))) bf16x8*)(kp+6144); kf[7]=*(const __attribute__((address_space(3))) bf16x8*)(kp+6656);
}
__device__ __forceinline__ void kload2(bf16x8*kf,lds_cptr kp,int j){ kf[2*j]=*(const __attribute__((address_space(3))) bf16x8*)(kp+j*2048); kf[2*j+1]=*(const __attribute__((address_space(3))) bf16x8*)(kp+j*2048+512); }
__device__ __forceinline__ s16x4 vtr(lds_cptr p){ return __builtin_bit_cast(s16x4,__builtin_amdgcn_ds_read_tr16_b64_v4i16((__attribute__((address_space(3))) v4i16_t*)p)); }
__device__ __forceinline__ float rowmax(const f32x16&p0,const f32x16&p1){
  float a=max3f(p0[0],p0[1],p1[0]),b=max3f(p0[2],p0[3],p1[1]);a=max3f(a,p1[2],p1[3]);
  #pragma unroll
  for(int r=4;r<16;r+=4){a=max3f(a,p0[r],p0[r+1]);b=max3f(b,p0[r+2],p0[r+3]);a=max3f(a,p1[r],p1[r+1]);b=max3f(b,p1[r+2],p1[r+3]);}
  const float m=max2f(a,b);
  auto rr=__builtin_amdgcn_permlane32_swap(__float_as_uint(m),__float_as_uint(m),false,false);
  return max2f(__uint_as_float(rr[0]),__uint_as_float(rr[1]));
}
__device__ __forceinline__ void pv(f32x16*o,int vb,bf16x8 pa0,bf16x8 pa1,bf16x8 pa2,bf16x8 pa3){
  #pragma unroll
  for(int d0=0;d0<2;++d0){s16x4 lo[4],hi[4];
    #pragma unroll
    for(int ks=0;ks<4;++ks){
      asm volatile("ds_read_b64_tr_b16 %0,%1 offset:%c2":"=&v"(lo[ks]):"v"(vb),"i"(d0*4096+ks*1024):"memory");
      asm volatile("ds_read_b64_tr_b16 %0,%1 offset:%c2":"=&v"(hi[ks]):"v"(vb),"i"(d0*4096+ks*1024+512):"memory");}
    asm volatile("s_waitcnt lgkmcnt(0)":::"memory");SBAR();
    #define PK(k) (bf16x8){lo[k][0],lo[k][1],lo[k][2],lo[k][3],hi[k][0],hi[k][1],hi[k][2],hi[k][3]}
    o[d0]=__builtin_amdgcn_mfma_f32_32x32x16_bf16(pa0,PK(0),o[d0],0,0,0);
    o[d0]=__builtin_amdgcn_mfma_f32_32x32x16_bf16(pa1,PK(1),o[d0],0,0,0);
    o[d0]=__builtin_amdgcn_mfma_f32_32x32x16_bf16(pa2,PK(2),o[d0],0,0,0);
    o[d0]=__builtin_amdgcn_mfma_f32_32x32x16_bf16(pa3,PK(3),o[d0],0,0,0);
    #undef PK
  }
}

template<int THRL,int VM,bool NOMAX> __device__ __forceinline__ void attn_unit(const bf16*Qb,const bf16*__restrict__ Kh,const bf16*__restrict__ Vh,bf16*Ob,const int NT,const int sp,float*wscr,char*shm){
  int tid_=threadIdx.x; asm volatile("":"+v"(tid_));
  const int tid=tid_,lane=tid&63,r32=lane&31,hi=lane>>5; const int wid=__builtin_amdgcn_readfirstlane(tid>>6);
  const bf16*Qw=Qb+(long)(wid*QBLK)*QOP;
  const unsigned lds0=(unsigned)(uintptr_t)shm;
  constexpr int LDS_WS_=LDS_V+3*VM*SLOTB, LDS_OST_=LDS_WS_+NW*64*4;
  float*wsf=(float*)(shm+LDS_WS_)+wid*64;
  const bf16*ksrc=Kh+(long)lane*KVP+wid*8;
  const bf16*vsrc=Vh+(long)(16*(wid&3)+(lane>>2))*KVP+(wid>>2)*32+(lane&3)*8;
  const unsigned kdst=lds0+LDS_K+wid*1024, vdst=lds0+LDS_V+wid*1024;
  #define DMA_K(t,slot) glds16(ksrc+(long)(t)*KVBLK*KVP,(unsigned)__builtin_amdgcn_readfirstlane(kdst+(slot)))
  #define DMA_V(t,slot) do{ glds16(vsrc+(long)(t)*KVBLK*KVP,(unsigned)__builtin_amdgcn_readfirstlane(vdst+VM*(slot))); if constexpr(VM==2) glds16(vsrc+64+(long)(t)*KVBLK*KVP,(unsigned)__builtin_amdgcn_readfirstlane(vdst+VM*(slot)+8192)); }while(0)
  const int vb0=(int)(lds0+LDS_V)+((lane>>4)&1)*32+(lane&3)*8+(4*hi+((lane&15)>>2))*64;
  const char*Kbase=shm+LDS_K; bf16x8 kf[8];
  const lds_cptr shm3=(lds_cptr)shm; const lds_cptr kp0=shm3+LDS_K+hi*1024+r32*16; const lds_cptr vp0=shm3+LDS_V+((lane>>4)&1)*32+(lane&3)*8+(4*hi+((lane&15)>>2))*64;
  if(wid>=4)__builtin_amdgcn_s_setprio(1);
  DMA_K(0,0);DMA_V(0,0);DMA_K(1,SLOTB);
  bf16x8 qr[4];
  #pragma unroll
  for(int d0=0;d0<4;++d0)qr[d0]=*reinterpret_cast<const bf16x8*>(&Qw[(long)r32*QOP+d0*16+hi*8]);
  const lds_cptr qpk=shm3+LDS_OST_+wid*4096+lane*16;
  if constexpr(VM==2){
    #pragma unroll
    for(int d0=0;d0<4;++d0)*(__attribute__((address_space(3))) bf16x8*)(const_cast<__attribute__((address_space(3))) char*>(qpk)+d0*1024)=qr[d0]; }
  constexpr int NO=(VM==1)?3:4;
  const bf16x8 ones8={16256,16256,16256,16256,16256,16256,16256,16256};
  float mhat=0.f,l_reg=0.f;f32x16 o[NO];
  #pragma unroll
  for(int d_=0;d_<NO;++d_)o[d_]=f32x16{};
 f32x16 negm=f32x16{}; if constexpr(VM==1){asm volatile("":"+v"(negm));}
  bool resc=false;
  #define START(P0,P1) do{ resc=false; if constexpr(!NOMAX) { const float rm=rowmax(P0,P1); const float dl=rm; mhat=fadd_s(mhat,dl); \
      _Pragma("unroll") for(int r=0;r<16;++r){P0[r]=fsub_s(P0[r],dl);P1[r]=fsub_s(P1[r],dl);} \
      if constexpr(VM==1){ _Pragma("unroll") for(int r=0;r<16;++r)negm[r]=-mhat; asm volatile("":"+v"(negm)); } } \
    _Pragma("unroll") for(int r=0;r<16;++r)P0[r]=__builtin_amdgcn_exp2f(P0[r]); }while(0)
  #define RESC() do{ if(!NOMAX&&resc){ asm volatile("s_waitcnt lgkmcnt(0)":::"memory"); \
      _Pragma("unroll") for(int d_=0;d_<NO;++d_) _Pragma("unroll") for(int r=0;r<16;++r)o[d_][r]*=wsf[crow(r,hi)]; } }while(0)
  f32x16 pA0,pA1,pB0,pB1;
  int sl_prev=0,sl_cur=0,sl_next=SLOTB;
  #define ROT() do{sl_prev=sl_cur;sl_cur=sl_next;sl_next=(sl_next==(NSLOT-1)*SLOTB)?0:sl_next+SLOTB;}while(0)
  DMA_K(2,2*SLOTB);
  WAIT_BAR(3);
  qkt(pA0,pA1,Kbase,qr,negm,r32,hi);asm volatile("s_nop 15\n\ts_nop 7":"+v"(pA0),"+v"(pA1));
  START(pA0,pA1);
  _Pragma("unroll") for(int r=0;r<16;++r)pA1[r]=__builtin_amdgcn_exp2f(pA1[r]);
  WAIT_BAR(0);
  DMA_K(3,0);DMA_V(1,SLOTB);
  ROT();
  kload8(kf,kp0+sl_cur);
  if constexpr(VM==2){WAIT_BAR(3);}else{WAIT_BAR(2);}
  s16x4 vlo[8],vhi[8]; u32x4 pw0,pw1,pw2,pw3;
  #define PKW(P,B) cvtpk_s(P[B],P[B+1])
  #define PAF(k) __builtin_bit_cast(bf16x8,pw##k)
  #define VFR(i) (bf16x8){vlo[i][0],vlo[i][1],vlo[i][2],vlo[i][3],vhi[i][0],vhi[i][1],vhi[i][2],vhi[i][3]}
  #define PIN(x) asm volatile("":"+v"(x))
  #define MX3(a,b,c) __builtin_fmaxf(__builtin_fmaxf((a),(b)),(c))
  #define GAPA(MF,A0,A1,A2,A3,W0,W1,PW) do{ MF; if constexpr(VM==2){ sacc+=A0; sacc+=A1; sacc+=A2; sacc+=A3; PIN(sacc); } W0; W1; PIN(PW); SBAR(); }while(0)
  #define EX(v) __builtin_amdgcn_exp2f(v)
  #define GAPB(MF,X,B,Y,D,KF) do{ MF; if constexpr(VM==2){ vlo[KF]=vtr(vp_+8192+(((KF)>>2)*4096+((KF)&3)*1024)); vhi[KF]=vtr(vp_+8192+(((KF)>>2)*4096+((KF)&3)*1024+512)); if constexpr(NOMAX){ Y[D]=EX(Y[D]); Y[D+1]=EX(Y[D+1]); } else { Y[D]=EX(Y[D]-mhat); Y[D+1]=EX(Y[D+1]-mhat); } PIN(Y); } else { X[B]=EX(X[B]); X[B+1]=EX(X[B+1]); X[B+2]=EX(X[B+2]); X[B+3]=EX(X[B+3]); PIN(X); } SBAR(); }while(0)
  #define VRD(i) do{ vlo[i]=vtr(vp_+(((i)>>2)*4096+((i)&3)*1024)); vhi[i]=vtr(vp_+(((i)>>2)*4096+((i)&3)*1024+512)); }while(0)
  #define KRD(G,j) do{ if(G){ kload2(kf,kp0+sl_next,j); SBAR(); } }while(0)
  #define QR(i) (VM==2? *(const __attribute__((address_space(3))) bf16x8*)(qpk+(i)*1024) : qr[i])
  #define CINIT ((VM==2||NOMAX)?f32x16{}:negm)
  #define STEP(C0,C1,P0,P1,t,GK,GV,GL) do{ SBAR(); \
    const lds_cptr vp_=vp0+VM*sl_prev; \
    VRD(0); SBAR(); float sacc=(VM==2)?(P0[0]+P0[1]):0.f; \
    GAPA(C0=__builtin_amdgcn_mfma_f32_32x32x16_bf16(kf[0],QR(0),CINIT,0,0,0), P0[2],P0[3],P0[4],P0[5],     pw0[0]=PKW(P0,0), pw0[1]=PKW(P0,2), pw0); \
    VRD(4); SBAR(); GAPA(C1=__builtin_amdgcn_mfma_f32_32x32x16_bf16(kf[1],QR(0),CINIT,0,0,0), P0[6],P0[7],P0[8],P0[9],     pw0[2]=PKW(P0,4), pw0[3]=PKW(P0,6), pw0); \
    VRD(1); SBAR(); GAPA(C0=__builtin_amdgcn_mfma_f32_32x32x16_bf16(kf[2],QR(1),C0,0,0,0),   P0[10],P0[11],P0[12],P0[13], pw1[0]=PKW(P0,8), pw1[1]=PKW(P0,10), pw1); \
    VRD(5); SBAR(); GAPA(C1=__builtin_amdgcn_mfma_f32_32x32x16_bf16(kf[3],QR(1),C1,0,0,0),   P0[14],P0[15],P1[0],P1[1],   pw1[2]=PKW(P0,12),pw1[3]=PKW(P0,14), pw1); \
    VRD(2); SBAR(); GAPA(C0=__builtin_amdgcn_mfma_f32_32x32x16_bf16(kf[4],QR(2),C0,0,0,0),   P1[2],P1[3],P1[4],P1[5],     pw2[0]=PKW(P1,0), pw2[1]=PKW(P1,2), pw2); \
    VRD(6); SBAR(); GAPA(C1=__builtin_amdgcn_mfma_f32_32x32x16_bf16(kf[5],QR(2),C1,0,0,0),   P1[6],P1[7],P1[8],P1[9],     pw2[2]=PKW(P1,4), pw2[3]=PKW(P1,6), pw2); \
    VRD(3); SBAR(); GAPA(C0=__builtin_amdgcn_mfma_f32_32x32x16_bf16(kf[6],QR(3),C0,0,0,0),   P1[10],P1[11],P1[12],P1[13], pw3[0]=PKW(P1,8), pw3[1]=PKW(P1,10), pw3); \
    VRD(7); SBAR(); GAPA(C1=__builtin_amdgcn_mfma_f32_32x32x16_bf16(kf[7],QR(3),C1,0,0,0),   P1[14],P1[15],0.f,0.f,       pw3[2]=PKW(P1,12),pw3[3]=PKW(P1,14), pw3); \
    if constexpr(VM==2) l_reg+=sacc; \
    if(GK){DMA_K((t)+3,sl_cur);} if(GV){DMA_V((t)+1,sl_next);} \
    if constexpr(!NOMAX) { float a=MX3(C0[0],C0[1],C1[0]),b=MX3(C0[2],C0[3],C1[1]); a=MX3(a,C1[2],C1[3]); \
      _Pragma("unroll") for(int r=4;r<16;r+=4){a=MX3(a,C0[r],C0[r+1]);b=MX3(b,C0[r+2],C0[r+3]);a=MX3(a,C1[r],C1[r+1]);b=MX3(b,C1[r+2],C1[r+3]);} \
      float rm=__builtin_fmaxf(a,b); { auto rr=__builtin_amdgcn_permlane32_swap(__float_as_uint(rm),__float_as_uint(rm),false,false); rm=__builtin_fmaxf(__uint_as_float(rr[0]),__uint_as_float(rr[1])); } \
      resc=false; if constexpr(VM==2) rm-=mhat; \
      if(__builtin_expect(__any(rm>(float)THRL),0)){ const float dl=__builtin_fmaxf(rm,0.f); mhat+=dl; \
        if constexpr(VM==1){ _Pragma("unroll") for(int r=0;r<16;++r){C0[r]-=dl;C1[r]-=dl;} \
        _Pragma("unroll") for(int r=0;r<16;++r)negm[r]=-mhat; asm volatile("":"+v"(negm)); } \
        const float f=__builtin_amdgcn_exp2f(-dl); l_reg*=f; if(hi==0)wsf[r32]=f; resc=true; } } \
    SBAR(); \
    GAPB(o[0]=__builtin_amdgcn_mfma_f32_32x32x16_bf16(PAF(0),VFR(0),o[0],0,0,0), C0,0, C0,0, 0); \
    GAPB(o[1]=__builtin_amdgcn_mfma_f32_32x32x16_bf16(PAF(0),VFR(4),o[1],0,0,0), C0,4, C0,2, 4); \
    KRD(GL,0); GAPB(o[0]=__builtin_amdgcn_mfma_f32_32x32x16_bf16(PAF(1),VFR(1),o[0],0,0,0), C0,8, C0,4, 1); \
    KRD(GL,1); GAPB(o[1]=__builtin_amdgcn_mfma_f32_32x32x16_bf16(PAF(1),VFR(5),o[1],0,0,0), C0,12, C0,6, 5); \
    KRD(GL,2); GAPB(o[0]=__builtin_amdgcn_mfma_f32_32x32x16_bf16(PAF(2),VFR(2),o[0],0,0,0), C1,0, C0,8, 2); \
    KRD(GL,3); GAPB(o[1]=__builtin_amdgcn_mfma_f32_32x32x16_bf16(PAF(2),VFR(6),o[1],0,0,0), C1,4, C0,10, 6); \
    GAPB(o[0]=__builtin_amdgcn_mfma_f32_32x32x16_bf16(PAF(3),VFR(3),o[0],0,0,0), C1,8, C0,12, 3); \
    GAPB(o[1]=__builtin_amdgcn_mfma_f32_32x32x16_bf16(PAF(3),VFR(7),o[1],0,0,0), C1,12, C0,14, 7); \
    if constexpr(VM==1){ o[2]=__builtin_amdgcn_mfma_f32_32x32x16_bf16(PAF(0),ones8,o[2],0,0,0); o[2]=__builtin_amdgcn_mfma_f32_32x32x16_bf16(PAF(1),ones8,o[2],0,0,0); \
      o[2]=__builtin_amdgcn_mfma_f32_32x32x16_bf16(PAF(2),ones8,o[2],0,0,0); o[2]=__builtin_amdgcn_mfma_f32_32x32x16_bf16(PAF(3),ones8,o[2],0,0,0); SBAR(); } \
    if constexpr(VM==2){ \
      o[2]=__builtin_amdgcn_mfma_f32_32x32x16_bf16(PAF(0),VFR(0),o[2],0,0,0); C1[0]=EX(C1[0]-(NOMAX?0.f:mhat)); C1[1]=EX(C1[1]-(NOMAX?0.f:mhat)); PIN(C1); SBAR(); \
      o[3]=__builtin_amdgcn_mfma_f32_32x32x16_bf16(PAF(0),VFR(4),o[3],0,0,0); C1[2]=EX(C1[2]-(NOMAX?0.f:mhat)); C1[3]=EX(C1[3]-(NOMAX?0.f:mhat)); PIN(C1); SBAR(); \
      o[2]=__builtin_amdgcn_mfma_f32_32x32x16_bf16(PAF(1),VFR(1),o[2],0,0,0); C1[4]=EX(C1[4]-(NOMAX?0.f:mhat)); C1[5]=EX(C1[5]-(NOMAX?0.f:mhat)); PIN(C1); SBAR(); \
      o[3]=__builtin_amdgcn_mfma_f32_32x32x16_bf16(PAF(1),VFR(5),o[3],0,0,0); C1[6]=EX(C1[6]-(NOMAX?0.f:mhat)); C1[7]=EX(C1[7]-(NOMAX?0.f:mhat)); PIN(C1); SBAR(); \
      o[2]=__builtin_amdgcn_mfma_f32_32x32x16_bf16(PAF(2),VFR(2),o[2],0,0,0); C1[8]=EX(C1[8]-(NOMAX?0.f:mhat)); C1[9]=EX(C1[9]-(NOMAX?0.f:mhat)); PIN(C1); SBAR(); \
      o[3]=__builtin_amdgcn_mfma_f32_32x32x16_bf16(PAF(2),VFR(6),o[3],0,0,0); C1[10]=EX(C1[10]-(NOMAX?0.f:mhat)); C1[11]=EX(C1[11]-(NOMAX?0.f:mhat)); PIN(C1); SBAR(); \
      o[2]=__builtin_amdgcn_mfma_f32_32x32x16_bf16(PAF(3),VFR(3),o[2],0,0,0); C1[12]=EX(C1[12]-(NOMAX?0.f:mhat)); C1[13]=EX(C1[13]-(NOMAX?0.f:mhat)); PIN(C1); SBAR(); \
      o[3]=__builtin_amdgcn_mfma_f32_32x32x16_bf16(PAF(3),VFR(7),o[3],0,0,0); C1[14]=EX(C1[14]-(NOMAX?0.f:mhat)); C1[15]=EX(C1[15]-(NOMAX?0.f:mhat)); PIN(C1); SBAR(); SBAR(); } \
    }while(0)
  int t=1;
  for(;t+5<NT;t+=2){
    STEP(pB0,pB1,pA0,pA1,t,true,true,true);     if constexpr(VM==2){WAIT_BAR(3);}else{WAIT_BAR(2);} RESC(); ROT();
    STEP(pA0,pA1,pB0,pB1,t+1,true,true,true);   if constexpr(VM==2){WAIT_BAR(3);}else{WAIT_BAR(2);} RESC(); ROT();
  }
  #define ENDW(tt) do{ if((tt)+3<NT){ if constexpr(VM==2){WAIT_BAR(3);}else{WAIT_BAR(2);} } else if((tt)+2<NT){ if constexpr(VM==2){WAIT_BAR(2);}else{WAIT_BAR(1);} } else {WAIT_BAR(0);} }while(0)
  for(;t+1<NT;t+=2){
    STEP(pB0,pB1,pA0,pA1,t,(t+3<NT),(t+1<NT),(t+1<NT));       ENDW(t);   RESC(); ROT();
    STEP(pA0,pA1,pB0,pB1,t+1,(t+4<NT),(t+2<NT),(t+2<NT));     ENDW(t+1); RESC(); ROT();
  }
  STEP(pB0,pB1,pA0,pA1,NT-1,false,false,false); RESC();
  { if constexpr(VM==2){ float sacc=pB0[0]+pB0[1]; _Pragma("unroll") for(int r=2;r<16;++r)sacc+=pB0[r]; _Pragma("unroll") for(int r=0;r<16;++r)sacc+=pB1[r]; l_reg+=sacc; }
    pw0=(u32x4){PKW(pB0,0),PKW(pB0,2),PKW(pB0,4),PKW(pB0,6)};pw1=(u32x4){PKW(pB0,8),PKW(pB0,10),PKW(pB0,12),PKW(pB0,14)};pw2=(u32x4){PKW(pB1,0),PKW(pB1,2),PKW(pB1,4),PKW(pB1,6)};pw3=(u32x4){PKW(pB1,8),PKW(pB1,10),PKW(pB1,12),PKW(pB1,14)};
    SBAR(); pv(o,vb0+VM*sl_cur,PAF(0),PAF(1),PAF(2),PAF(3)); if constexpr(VM==2) pv(o+2,vb0+VM*sl_cur+8192,PAF(0),PAF(1),PAF(2),PAF(3));
    if constexpr(VM==1){ o[2]=__builtin_amdgcn_mfma_f32_32x32x16_bf16(PAF(0),ones8,o[2],0,0,0); o[2]=__builtin_amdgcn_mfma_f32_32x32x16_bf16(PAF(1),ones8,o[2],0,0,0); o[2]=__builtin_amdgcn_mfma_f32_32x32x16_bf16(PAF(2),ones8,o[2],0,0,0); o[2]=__builtin_amdgcn_mfma_f32_32x32x16_bf16(PAF(3),ones8,o[2],0,0,0); } }
  #undef PKW
  #undef PAF
  #undef VFR
  #undef PIN
  #undef MX3
  #undef GAPA
  #undef GAPB
  #undef EX
  #undef VRD
  #undef KRD
  #undef STEP
  #undef ENDW
  {auto rr=__builtin_amdgcn_permlane32_swap(__float_as_uint(l_reg),__float_as_uint(l_reg),false,false);l_reg=__uint_as_float(rr[0])+__uint_as_float(rr[1]);}
  if(hi==0)wsf[32+r32]=l_reg;asm volatile("s_waitcnt lgkmcnt(0)":::"memory");
  float rli[16];
  #pragma unroll
  for(int r=0;r<16;++r)rli[r]=__builtin_amdgcn_rcpf((VM==1)?o[2][r]:wsf[32+crow(r,hi)]);
  bf16*Ow=Ob+(long)(wid*QBLK)*QOP;
  bf16*stg=(bf16*)(shm+LDS_OST_)+wid*2048;
  if(sp<0){
    #pragma unroll
    for(int r=0;r<16;++r){const int orow=crow(r,hi);
      #pragma unroll
      for(int d0=0;d0<2;++d0)stg[orow*64+d0*32+r32]=__float2bfloat16(o[d0][r]*rli[r]);}
    asm volatile("s_waitcnt lgkmcnt(0)":::"memory");
    #pragma unroll
    for(int i=0;i<4;++i){const int row=i*8+(lane>>3),ch=lane&7; const u32x4 v=*(const u32x4*)(stg+row*64+ch*8); *(u32x4*)(Ow+(long)row*QOP+ch*8)=v;}
  } else {
    int lane_l=threadIdx.x&63; asm volatile("":"+v"(lane_l));
    float*sc=wscr+sp*2048+lane_l;
    #pragma unroll
    for(int d0=0;d0<2;++d0)
      #pragma unroll
      for(int r=0;r<16;++r)sc[(d0*16+r)*64]=o[d0][r]*rli[r];
    if constexpr(VM==2){ float*sc2=sc+4096;
      #pragma unroll
      for(int d0=0;d0<2;++d0)
        #pragma unroll
        for(int r=0;r<16;++r)sc2[(d0*16+r)*64]=o[2+d0][r]*rli[r]; }
  }
  __builtin_amdgcn_s_setprio(0);
  asm volatile("s_waitcnt vmcnt(0) lgkmcnt(0)\n\ts_barrier":::"memory");
  #undef DMA_K
  #undef DMA_V
  #undef START
  #undef RESC
  #undef ROT
}
__device__ __forceinline__ void b_combine(const float*wscr,const float lam,const float*gout,bf16*Ob,char*shm){
  int tid_=threadIdx.x; asm volatile("":"+v"(tid_));
  const int tid=tid_,lane=tid&63,r32=lane&31,hi=lane>>5; const int wid=__builtin_amdgcn_readfirstlane(tid>>6);
  f32x16 dl[2],dh[2];
  int lane_l=threadIdx.x&63; asm volatile("":"+v"(lane_l));
  #pragma unroll
  for(int d0=0;d0<2;++d0){
    const float*p0=wscr+lane_l+d0*1024; const float*p1=p0+2048; const float*p2=p0+4096; const float*p3=p0+6144;
    asm volatile("":"+v"(p0),"+v"(p1),"+v"(p2),"+v"(p3));
    #pragma unroll
    for(int r=0;r<16;++r){ dl[d0][r]=p0[r*64]-lam*p1[r*64]; }
    asm volatile("":::"memory");
    #pragma unroll
    for(int r=0;r<16;++r){ dh[d0][r]=p2[r*64]-lam*p3[r*64]; }
    asm volatile("":::"memory");
  }
  float rs[16];
  #pragma unroll
  for(int r=0;r<16;++r){ float s=dl[0][r]*dl[0][r]+dl[1][r]*dl[1][r]+dh[0][r]*dh[0][r]+dh[1][r]*dh[1][r];
    s+=__shfl_xor(s,1); s+=__shfl_xor(s,2); s+=__shfl_xor(s,4); s+=__shfl_xor(s,8); s+=__shfl_xor(s,16);
    rs[r]=(1.0f-LAM_INIT)/sqrtf(s*(1.0f/128.0f)+RMS_EPS); }
  const float g00=gout[r32],g01=gout[32+r32],g10=gout[64+r32],g11=gout[96+r32];
  bf16*Ow=Ob+(long)(wid*QBLK)*QOP;
  bf16*stg=(bf16*)(shm+LDS_OST)+wid*2048;
  #pragma unroll
  for(int r=0;r<16;++r){const int orow=crow(r,hi);
    stg[orow*64+r32]=__float2bfloat16(dl[0][r]*rs[r]*g00); stg[orow*64+32+r32]=__float2bfloat16(dl[1][r]*rs[r]*g01);}
  asm volatile("s_waitcnt lgkmcnt(0)":::"memory");
  #pragma unroll
  for(int i=0;i<4;++i){const int row=i*8+(lane>>3),ch=lane&7; const u32x4 v=*(const u32x4*)(stg+row*64+ch*8); *(u32x4*)(Ow+(long)row*QOP+ch*8)=v;}
  asm volatile("s_waitcnt lgkmcnt(0)":::"memory");
  #pragma unroll
  for(int r=0;r<16;++r){const int orow=crow(r,hi);
    stg[orow*64+r32]=__float2bfloat16(dh[0][r]*rs[r]*g10); stg[orow*64+32+r32]=__float2bfloat16(dh[1][r]*rs[r]*g11);}
  asm volatile("s_waitcnt lgkmcnt(0)":::"memory");
  #pragma unroll
  for(int i=0;i<4;++i){const int row=i*8+(lane>>3),ch=lane&7; const u32x4 v=*(const u32x4*)(stg+row*64+ch*8); *(u32x4*)(Ow+(long)row*QOP+64+ch*8)=v;}
  asm volatile("s_waitcnt vmcnt(0) lgkmcnt(0)\n\ts_barrier":::"memory");
}
constexpr int ATTN_LDS_BYTES=LDS_BYTES;
#undef SBAR
#undef WAIT_BAR
}

constexpr int NWAVES = 8;
constexpr size_t MiB = 1u << 20;
constexpr size_t WS_SSQ1 = 0, WS_SSQ2 = 0;
constexpr size_t WS_BAR = 3 * MiB, BAR_ZERO_BYTES = 16384;
constexpr size_t WS_W1GU = 6 * MiB;
constexpr size_t WS_W1D = 17 * MiB;
constexpr size_t WS_WIN = 22 * MiB + 512 * 1024;
constexpr size_t WS_WG = 27 * MiB;
constexpr size_t WS_WAB = 31 * MiB;
constexpr size_t WS_WOUT = 35 * MiB;
constexpr size_t WS_W2GU = 37 * MiB;
constexpr size_t WS_W2D = 48 * MiB;
constexpr size_t WS_ROPE = 53 * MiB + 512 * 1024;
constexpr size_t WS_RA = 56 * MiB;
constexpr size_t WS_RB = 152 * MiB;
constexpr size_t WS_RC = 248 * MiB;
constexpr size_t WS_ASCR = WS_RC + 120 * MiB;
constexpr size_t WS_END = 512 * MiB;
static_assert(WS_RC + (size_t)MROWS * DFF * 2 <= WS_END, "ws map");
constexpr int LDS_BYTES = 147456;

#define GAS __attribute__((address_space(1)))
#define LAS __attribute__((address_space(3)))
typedef unsigned short bf16;
typedef unsigned v4u __attribute__((ext_vector_type(4)));
typedef unsigned v2u __attribute__((ext_vector_type(2)));
typedef float f32x4 __attribute__((ext_vector_type(4)));
typedef float f32x2 __attribute__((ext_vector_type(2)));
#define LDS_WAIT() asm volatile("s_waitcnt lgkmcnt(0)" ::: "memory")
__device__ __forceinline__ unsigned pk2(float lo, float hi) { return pg8::cvt_pk_bf16(lo, hi); }
__device__ __forceinline__ float wave_sum(float v) {
#pragma unroll
    for (int o = 1; o < 64; o <<= 1) v += __shfl_xor(v, o);
    return v;
}

__device__ __forceinline__ int map_row(int mode, int n0) {
    switch (mode) {
        case 1: return 256 * (n0 >> 7) + (n0 & 127);
        case 2: return 256 * (n0 >> 7) + 128 + (n0 & 127);
        case 3:
            { const int x = (n0 < 512) ? n0 : (n0 < 768) ? n0 + 512 : (n0 < 1280) ? n0 - 256 : n0;
              return (x & ~255) + 128 * ((x >> 5) & 1) + 32 * ((x >> 6) & 3); }
        case 4: return n0 < 1024 ? 256 * (n0 >> 7) + (n0 & 127) : 256 * ((n0 - 1024) >> 7) + 128 + ((n0 - 1024) & 127);
        default: return n0;
    }
}
__device__ __forceinline__ void p0_transpose_item(const float* W, int K, int N, bf16* WT, int ldk, int kofs, int mode, LAS float* scr, int item, int lane) {
    const int nblk = N / 32, kb = item / nblk, nb = item % nblk, k0 = 64 * kb, n0 = 32 * nb;
#pragma unroll 8
    for (int i = 0; i < 32; ++i) { const int kk = 2 * i + (lane >> 5); scr[kk * 33 + (lane & 31)] = W[(size_t)(k0 + kk) * N + n0 + (lane & 31)]; }
    LDS_WAIT(); asm volatile("" ::: "memory");
    const int c = lane & 7; const int r0 = map_row(mode, n0);
#pragma unroll
    for (int j = 0; j < 4; ++j) { const int n = (lane >> 3) + 8 * j; const LAS float* s = scr + (8 * c) * 33 + n;
        v4u o; o.x = pk2(s[0 * 33], s[1 * 33]); o.y = pk2(s[2 * 33], s[3 * 33]); o.z = pk2(s[4 * 33], s[5 * 33]); o.w = pk2(s[6 * 33], s[7 * 33]);
        *(v4u*)(WT + (size_t)(r0 + n) * ldk + kofs + k0 + 8 * c) = o; }
    LDS_WAIT(); asm volatile("" ::: "memory");
}
__device__ __forceinline__ void sincos_d(double a, float& c, float& s) {
    const double q = rint(a * 0.63661977236758134308);
    double r = fma(-q, 1.57079632679489655800e+00, a); r = fma(-q, 6.12323399573676603587e-17, r);
    const int quad = (int)((long long)q & 3);
    const double r2 = r * r;
    const double sp = r * (1.0 + r2 * (-1.0 / 6.0 + r2 * (1.0 / 120.0 + r2 * (-1.0 / 5040.0 + r2 * (1.0 / 362880.0 + r2 * (-1.0 / 39916800.0 + r2 * (1.0 / 6227020800.0 + r2 * (-1.0 / 1307674368000.0))))))));
    const double cp = 1.0 + r2 * (-0.5 + r2 * (1.0 / 24.0 + r2 * (-1.0 / 720.0 + r2 * (1.0 / 40320.0 + r2 * (-1.0 / 3628800.0 + r2 * (1.0 / 479001600.0 + r2 * (-1.0 / 87178291200.0 + r2 * (1.0 / 20922789888000.0))))))));
    double ss, cc;
    if (quad == 0) { ss = sp; cc = cp; } else if (quad == 1) { ss = cp; cc = -sp; } else if (quad == 2) { ss = -sp; cc = -cp; } else { ss = -cp; cc = sp; }
    c = (float)cc; s = (float)ss;
}
__device__ __forceinline__ float inv_freq(int i) {
    switch (i) {
        case 0: return 1.000000000e+00f; case 1: return 5.623413324e-01f; case 2: return 3.162277639e-01f; case 3: return 1.778279394e-01f;
        case 4: return 1.000000015e-01f; case 5: return 5.623413250e-02f; case 6: return 3.162277490e-02f; case 7: return 1.778279431e-02f;
        case 8: return 9.999999776e-03f; case 9: return 5.623413250e-03f; case 10: return 3.162277630e-03f; case 11: return 1.778279431e-03f;
        case 12: return 1.000000047e-03f; case 13: return 5.623413017e-04f; case 14: return 3.162277571e-04f; case 15: return 1.778279402e-04f;
        case 16: return 1.000000000e+00f; case 17: return 1.939227432e-01f; case 18: return 3.760603070e-02f; case 19: return 7.292664610e-03f;
        case 20: return 1.414213562e-03f; case 21: return 2.742481884e-04f; case 22: return 5.318296098e-05f; default: return 1.031338616e-05f;
    }
}

#define XB_TMO      128
#define XB_XCNT(j)  (256  + 64 * (j))
#define XB_XSUB(j)  (1280 + 64 * (j))
#define XB_XGEN(j)  (2304 + 64 * (j))
#define XB_TOP      3328
#define XB_TOPGEN   3392
#define XCD_BAR_WORDS 3456
#define XB_SPIN_CAP (1u << 18)

__device__ __forceinline__ unsigned xb_ld(unsigned* p)              { return __hip_atomic_load(p, __ATOMIC_RELAXED, __HIP_MEMORY_SCOPE_AGENT); }
__device__ __forceinline__ unsigned xb_add(unsigned* p, unsigned v) { return __hip_atomic_fetch_add(p, v, __ATOMIC_RELAXED, __HIP_MEMORY_SCOPE_AGENT); }
__device__ __forceinline__ unsigned xb_xcc_id() { return (unsigned)__builtin_amdgcn_s_getreg((3 << 11) | 20) & 0xFu; }
#define XB_SPIN(cond, bar) do { unsigned _sp = 0; while (cond) { __builtin_amdgcn_s_sleep(1); \
    if ((++_sp & 255u) == 0u) { if (xb_ld(&(bar)[XB_TMO])) break; if (_sp > XB_SPIN_CAP) { atomicAdd(&(bar)[XB_TMO], 1u); break; } } } } while (0)

struct XcdBarrier {
    unsigned* bar; unsigned x;
    volatile LAS unsigned* st;
};

__device__ __forceinline__ XcdBarrier xcd_barrier_post(unsigned* bar, volatile LAS unsigned* st) {
    XcdBarrier b; b.bar = bar; b.x = xb_xcc_id(); b.st = st;
    if (threadIdx.x == 0) (void)xb_add(&bar[XB_XCNT(b.x)], 1u);
    return b;
}
__device__ __forceinline__ void xcd_barrier_complete(unsigned* bar, unsigned x, unsigned& nloc, unsigned& nx) {
    const unsigned G = gridDim.x * gridDim.y * gridDim.z;
    unsigned sum, cnt, mine, sp = 0u;
    for (;;) {
        sum = 0u; cnt = 0u; mine = 0u;
#pragma unroll
        for (unsigned j = 0; j < 16; ++j) { const unsigned c = xb_ld(&bar[XB_XCNT(j)]); sum += c; cnt += (c > 0u) ? 1u : 0u; mine = (j == x) ? c : mine; }
        if (sum == G) break;
        __builtin_amdgcn_s_sleep(1);
        if ((++sp & 255u) == 0u) { if (xb_ld(&bar[XB_TMO])) break; if (sp > XB_SPIN_CAP) { atomicAdd(&bar[XB_TMO], 1u); break; } }
    }
    nloc = mine > 0u ? mine : 1u; nx = cnt > 0u ? cnt : 1u;
}

__device__ __forceinline__ void xcd_barrier(const XcdBarrier& b) {
    asm volatile("s_waitcnt vmcnt(0)" ::: "memory");
    __syncthreads();
    if (threadIdx.x == 0) {
        unsigned* bar = b.bar;
        __builtin_amdgcn_s_waitcnt(0);
        unsigned nloc = b.st[0], nx = b.st[1];
        if (nloc == 0u) { xcd_barrier_complete(bar, b.x, nloc, nx); b.st[0] = nloc; b.st[1] = nx; }
        const unsigned old = xb_add(&bar[XB_XSUB(b.x)], 1u);
        const unsigned gen = old / nloc;
        if (old + 1u == (gen + 1u) * nloc) {
            __builtin_amdgcn_fence(__ATOMIC_RELEASE, "agent");
            asm volatile("s_waitcnt vmcnt(0)" ::: "memory");
            const unsigned og = xb_add(&bar[XB_TOP], 1u);
            const unsigned tg = og / nx;
            if (og + 1u == (tg + 1u) * nx) xb_add(&bar[XB_TOPGEN], 1u);
            else XB_SPIN(xb_ld(&bar[XB_TOPGEN]) == tg, bar);
            __builtin_amdgcn_fence(__ATOMIC_ACQUIRE, "agent");
            xb_add(&bar[XB_XGEN(b.x)], 1u);
            asm volatile("s_waitcnt vmcnt(0)" ::: "memory");
        } else {
            XB_SPIN(xb_ld(&bar[XB_XGEN(b.x)]) == gen, bar);
            __builtin_amdgcn_fence(__ATOMIC_ACQUIRE, "agent");
            asm volatile("s_waitcnt vmcnt(0)" ::: "memory");
        }
    }
    __syncthreads();
}

struct Args { const float* in[25]; float* out_; unsigned char* ws_; };

#define ATT_UNITS(NM_) do { \
        for (int i = vcu; i < 256; i += G) { const int seq = i >> 7, head = (i >> 5) & 3, qb = i & 31; const long rb = (long)seq * 8192; \
            for (int sp = 0; sp < 2; ++sp) { const int jm = sp, vh = 0; \
                attn_body::attn_unit<8, 2, NM_>(QOa + (rb + qb * 256) * QOP + 512 + head * 128 + jm * 64, KVa + rb * KVP + 256 + head * 128 + jm * 64, KVa + rb * KVP + 768 + head * 128 + vh * 64, \
                                        (attn_body::bf16*)QO + (rb + qb * 256) * QOP + 512 + head * 128, 128, sp, wscr, shm); } \
            attn_body::b_combine(wscr, lam, gout, (attn_body::bf16*)QO + (rb + qb * 256) * QOP + 512 + head * 128, shm); } \
        for (int i = vcu; i < 512; i += G) { const int seq = i >> 6, head = (i >> 4) & 3, qb = i & 15; const long rb = (long)M_P + (long)seq * 4096; \
            for (int sp = 0; sp < 2; ++sp) { const int jm = sp, vh = 0; \
                attn_body::attn_unit<8, 2, NM_>(QOa + (rb + qb * 256) * QOP + 512 + head * 128 + jm * 64, KVa + rb * KVP + 256 + head * 128 + jm * 64, KVa + rb * KVP + 768 + head * 128 + vh * 64, \
                                        (attn_body::bf16*)QO + (rb + qb * 256) * QOP + 512 + head * 128, 64, sp, wscr, shm); } \
            attn_body::b_combine(wscr, lam, gout, (attn_body::bf16*)QO + (rb + qb * 256) * QOP + 512 + head * 128, shm); } \
        for (int i = vcu; i < 512; i += G) { const int seq = i >> 8, head = (i >> 5) & 7, qb = i & 31; const long rb = (long)seq * 8192; \
            attn_body::attn_unit<8, 1, NM_>(QOa + (rb + qb * 256) * QOP + head * 64, KVa + rb * KVP + (head >> 2) * 64, KVa + rb * KVP + 128 + (head >> 2) * 64, \
                                    (attn_body::bf16*)QO + (rb + qb * 256) * QOP + head * 64, 128, -1, wscr, shm); } \
        for (int i = vcu; i < 1024; i += G) { const int seq = i >> 7, head = (i >> 4) & 7, qb = i & 15; const long rb = (long)M_P + (long)seq * 4096; \
            attn_body::attn_unit<8, 1, NM_>(QOa + (rb + qb * 256) * QOP + head * 64, KVa + rb * KVP + (head >> 2) * 64, KVa + rb * KVP + 128 + (head >> 2) * 64, \
                                    (attn_body::bf16*)QO + (rb + qb * 256) * QOP + head * 64, 64, -1, wscr, shm); } \
        } while (0)
__global__ void __launch_bounds__(NWAVES * 64, 2) mk_fwd(Args args) {
    extern __shared__ __attribute__((aligned(16))) unsigned char lds[];
    cg::grid_group grid = cg::this_grid();
    LAS unsigned char* ldsl = (LAS unsigned char*)lds;
    if (threadIdx.x < 2) ((volatile LAS unsigned*)(ldsl + 131072))[threadIdx.x] = 0u;
    __syncthreads();
    if (args.ws_ == nullptr) { grid.sync(); }
    const XcdBarrier xbar = xcd_barrier_post((unsigned*)(args.ws_ + WS_BAR), (volatile LAS unsigned*)(ldsl + 131072));
#define GRID_SYNC() do { asm volatile("s_waitcnt vmcnt(0) lgkmcnt(0)" ::: "memory"); grid.sync(); __builtin_amdgcn_fence(__ATOMIC_ACQUIRE, "agent"); asm volatile("s_waitcnt vmcnt(0)" ::: "memory"); } while (0)
#define XSYNC() xcd_barrier(xbar)
#define PHASE_IDS() int tid = threadIdx.x; asm volatile("" : "+v"(tid)); const int lane = tid & 63, wave = __builtin_amdgcn_readfirstlane(tid >> 6); const int gw = vcu * NWAVES + wave, NGW = G * NWAVES; (void)lane; (void)gw; (void)NGW
    const int G = gridDim.x; const int bx = blockIdx.x; const int vcu = (G % 8 == 0) ? (bx % 8) * (G / 8) + bx / 8 : bx;
#define ws (args.ws_)
#define xp (args.in[0])
#define xs (args.in[1])
#define out (args.out_)
#define ssq1 ((float*)(args.ws_ + WS_SSQ1))
#define ssq2 ((float*)(args.ws_ + WS_SSQ2))
#define rope ((f32x2*)(args.ws_ + WS_ROPE))
#define W1GU ((bf16*)(args.ws_ + WS_W1GU))
#define W1D ((bf16*)(args.ws_ + WS_W1D))
#define WIN ((bf16*)(args.ws_ + WS_WIN))
#define WG ((bf16*)(args.ws_ + WS_WG))
#define WAB ((bf16*)(args.ws_ + WS_WAB))
#define WOUT ((bf16*)(args.ws_ + WS_WOUT))
#define W2GU ((bf16*)(args.ws_ + WS_W2GU))
#define W2D ((bf16*)(args.ws_ + WS_W2D))
#define XN ((bf16*)(args.ws_ + WS_RA))
#define TB ((bf16*)(args.ws_ + WS_RA))
#define QO ((bf16*)(args.ws_ + WS_RB))
#define XN3 ((bf16*)(args.ws_ + WS_RB))
#define HB ((bf16*)(args.ws_ + WS_RC))
#define KV ((bf16*)(args.ws_ + WS_RC))
#define GB ((bf16*)(args.ws_ + WS_RC))

    {
        PHASE_IDS();
        LAS float* scr = (LAS float*)(ldsl + wave * 16384);
        constexpr int I_GU = (DM / 64) * (DFF / 32), I_D = (DFF / 64) * (DM / 32), I_IN = (DM / 64) * (2304 / 32), I_G = (DM / 64) * (2048 / 32), I_OA = (512 / 64) * (DM / 32), I_OUT = (DM / 64) * (DM / 32);
        constexpr int NITEMS = 2 * (2 * I_GU + I_D) + I_IN + I_G + 2 * I_OA + I_OUT;
        for (int it = gw; it < NITEMS; it += NGW) {
            int r = it;
            if (r < I_GU) { p0_transpose_item(args.in[3], DM, DFF, W1GU, DM, 0, 1, scr, r, lane); continue; } r -= I_GU;
            if (r < I_GU) { p0_transpose_item(args.in[4], DM, DFF, W1GU, DM, 0, 2, scr, r, lane); continue; } r -= I_GU;
            if (r < I_D) { p0_transpose_item(args.in[5], DFF, DM, W1D, DFF, 0, 0, scr, r, lane); continue; } r -= I_D;
            if (r < I_GU) { p0_transpose_item(args.in[22], DM, DFF, W2GU, DM, 0, 1, scr, r, lane); continue; } r -= I_GU;
            if (r < I_GU) { p0_transpose_item(args.in[23], DM, DFF, W2GU, DM, 0, 2, scr, r, lane); continue; } r -= I_GU;
            if (r < I_D) { p0_transpose_item(args.in[24], DFF, DM, W2D, DFF, 0, 0, scr, r, lane); continue; } r -= I_D;
            if (r < I_IN) { p0_transpose_item(args.in[7], DM, 2304, WIN, DM, 0, 3, scr, r, lane); continue; } r -= I_IN;
            if (r < I_G) { p0_transpose_item(args.in[8], DM, 2048, WG, DM, 0, 4, scr, r, lane); continue; } r -= I_G;
            if (r < I_OA) { p0_transpose_item(args.in[18], 512, DM, WAB, DM, 0, 1, scr, r, lane); continue; } r -= I_OA;
            if (r < I_OA) { p0_transpose_item(args.in[19], 512, DM, WAB, DM, 512, 2, scr, r, lane); continue; } r -= I_OA;
            p0_transpose_item(args.in[20], DM, DM, WOUT, DM, 0, 0, scr, r, lane);
        }
        for (int idx = bx * 512 + tid; idx < 2048 * 64; idx += G * 512) { const int row = idx >> 6, ch = idx & 63; const int k0 = (((row & 255) < 128) ? 512 : 0) + ch * 8;
            *(v4u*)(WAB + (size_t)row * DM + k0) = (v4u){0u, 0u, 0u, 0u}; }
        for (int idx = bx * 512 + tid; idx < 8192 * 40; idx += G * 512) { const int t = idx / 40, i = idx % 40;
            float ang; if (i < 16) ang = (float)(t >> 6) * inv_freq(i); else if (i < 32) ang = (float)(t & 63) * inv_freq(i - 16); else ang = (float)t * inv_freq(16 + (i - 32));
            float c, s; sincos_d((double)ang, c, s); rope[idx] = (f32x2){c, s}; }
        const float* g1 = args.in[2]; f32x4 gv[4];
#pragma unroll
        for (int j = 0; j < 4; ++j) gv[j] = *((const f32x4*)g1 + lane + 64 * j);
        for (int m = gw; m < MROWS; m += NGW) {
            const float* xr = (m < M_P) ? xp + (size_t)m * DM : xs + (size_t)(m - M_P) * DM;
            f32x4 v[4]; float s = 0.f;
#pragma unroll
            for (int j = 0; j < 4; ++j) { v[j] = *((const f32x4*)xr + lane + 64 * j); s += (v[j].x * v[j].x + v[j].y * v[j].y) + (v[j].z * v[j].z + v[j].w * v[j].w); }
            const float rs = 1.0f / sqrtf(wave_sum(s) * (1.0f / DM) + RMS_EPS);
            v2u* o8 = (v2u*)(XN + (size_t)m * DM) + lane;
#pragma unroll
            for (int j = 0; j < 4; ++j) { const f32x4 y = v[j] * rs * gv[j]; o8[64 * j] = (v2u){pk2(y.x, y.y), pk2(y.z, y.w)}; }
        }
    }
    XSYNC();

    {
        pg8::Gemm g{XN, W1GU, MROWS, 2 * DFF, DM, DM}; pg8::StaticOrder S; S.init(MROWS, 2 * DFF, G, bx);
        pg8::EpiSwiGLU E{HB, nullptr};
        pg8::gemm_phase<pg8::EpiSwiGLU>(ldsl, g, S, E);
    }
    XSYNC();
    {
        pg8::Gemm g{HB, W1D, MROWS, DM, DFF, DFF}; pg8::StaticOrder S; S.init(MROWS, DM, G, bx);
        pg8::EpiRes<1, true> E{xp, xs, out, XN, args.in[6], ssq1};
        pg8::gemm_phase<pg8::EpiRes<1, true>>(ldsl, g, S, E);
    }
    XSYNC();
    {
        pg8::Gemm g{XN, WIN, MROWS, 2304, DM, DM}; pg8::StaticOrder S; S.init(MROWS, 2304, G, bx);
        pg8::EpiInProjPrep E{QO, KV, ssq1, (const float*)rope, args.in[9], args.in[10], args.in[11], args.in[12]};
        pg8::gemm_phase<pg8::EpiInProjPrep>(ldsl, g, S, E);
    }
    XSYNC();
    {
        PHASE_IDS();
        float lam;
        { const float a = args.in[13][lane] * args.in[14][lane], b = args.in[15][lane] * args.in[16][lane];
          lam = expf(wave_sum(a)) - expf(wave_sum(b)) + LAM_INIT; }
        float* wscr = (float*)(ws + WS_ASCR) + ((size_t)bx * NWAVES + wave) * 8192;
        const attn_body::bf16* QOa = (const attn_body::bf16*)QO; const attn_body::bf16* KVa = (const attn_body::bf16*)KV;
        const float* gout = args.in[17];
        char* shm = (char*)lds;
        bool nomax; {
          float ga = fabsf(args.in[9][lane]), gk = fabsf(args.in[10][lane]), gb = fabsf(args.in[11][lane]), gl = fabsf(args.in[12][lane]);
#pragma unroll
          for (int o_ = 1; o_ < 64; o_ <<= 1) { ga = fmaxf(ga, __shfl_xor(ga, o_)); gk = fmaxf(gk, __shfl_xor(gk, o_)); gb = fmaxf(gb, __shfl_xor(gb, o_)); gl = fmaxf(gl, __shfl_xor(gl, o_)); }
          const float bnd = 64.0f * attn_body::C2 * fmaxf(ga * gk, gb * gl) * 1.02f;
          nomax = __builtin_amdgcn_readfirstlane((int)(bnd <= 40.0f)) != 0; }
        if (nomax) { ATT_UNITS(true); } else { ATT_UNITS(false); }
    }
    XSYNC();
    {
        pg8::Gemm g{XN, WG, MROWS, 2048, DM, DM}; pg8::StaticOrder S; S.init(MROWS, 2048, G, bx);
        pg8::EpiGate E{GB, ssq1};
        pg8::gemm_phase<pg8::EpiGate>(ldsl, g, S, E);
    }
    XSYNC();
    {
        pg8::Gemm g{QO, WAB, MROWS, 2048, DM, QOP}; pg8::StaticOrder S; S.init(MROWS, 2048, G, bx);
        pg8::EpiMerge E{GB, TB};
        pg8::gemm_phase<pg8::EpiMerge, true, true>(ldsl, g, S, E);
    }
    XSYNC();
    {
        pg8::Gemm g{TB, WOUT, MROWS, DM, DM, DM}; pg8::StaticOrder S; S.init(MROWS, DM, G, bx);
        pg8::EpiRes<2, true> E{out, out + (size_t)M_P * DM, out, XN3, args.in[21], ssq2};
        pg8::gemm_phase<pg8::EpiRes<2, true>>(ldsl, g, S, E);
    }
    XSYNC();
    {
        pg8::Gemm g{XN3, W2GU, MROWS, 2 * DFF, DM, DM}; pg8::StaticOrder S; S.init(MROWS, 2 * DFF, G, bx);
        pg8::EpiSwiGLU E{HB, ssq2};
        pg8::gemm_phase<pg8::EpiSwiGLU>(ldsl, g, S, E);
    }
    XSYNC();
    {
        pg8::Gemm g{HB, W2D, MROWS, DM, DFF, DFF}; pg8::StaticOrder S; S.init(MROWS, DM, G, bx);
        pg8::EpiRes<1, false> E{out, out + (size_t)M_P * DM, out, nullptr, nullptr, nullptr};
        pg8::gemm_phase<pg8::EpiRes<1, false>>(ldsl, g, S, E);
    }
#undef ws
#undef xp
#undef xs
#undef out
#undef ssq1
#undef ssq2
#undef rope
#undef W1GU
#undef W1D
#undef WIN
#undef WG
#undef WAB
#undef WOUT
#undef W2GU
#undef W2D
#undef XN
#undef TB
#undef QO
#undef XN3
#undef HB
#undef KV
#undef GB
}

extern "C" void kernel_launch(void* const* d_in, const int* in_sizes, int n_in, void* d_out, int out_size, void* d_ws, size_t ws_size, hipStream_t stream) {
    static int grid = 0;
    if (grid == 0) {
        if (n_in != 25 || out_size != MROWS * DM || ws_size < WS_END) { fprintf(stderr, "kernel_launch: unexpected shapes (n_in %d, out %d, ws %zu)\n", n_in, out_size, ws_size); grid = -1; return; }
        int dev = 0, cus = 0, per_cu = 0;
        if (hipGetDevice(&dev) != hipSuccess || hipDeviceGetAttribute(&cus, hipDeviceAttributeMultiprocessorCount, dev) != hipSuccess) { grid = -1; return; }
        if (hipFuncSetAttribute((const void*)mk_fwd, hipFuncAttributeMaxDynamicSharedMemorySize, LDS_BYTES) != hipSuccess) { fprintf(stderr, "kernel_launch: hipFuncSetAttribute failed\n"); grid = -1; return; }
        if (hipOccupancyMaxActiveBlocksPerMultiprocessor(&per_cu, (const void*)mk_fwd, NWAVES * 64, LDS_BYTES) != hipSuccess || per_cu < 1) { fprintf(stderr, "kernel_launch: occupancy query says %d\n", per_cu); per_cu = 1; }
        (void)hipGetLastError();
        grid = cus;
    }
    if (grid < 0) return;
    (void)hipMemsetAsync((char*)d_ws + WS_BAR, 0, BAR_ZERO_BYTES, stream);
    Args a{};
    for (int i = 0; i < 25; ++i) a.in[i] = (const float*)d_in[i];
    a.out_ = (float*)d_out; a.ws_ = (unsigned char*)d_ws;
    void* kargs[] = {&a};
    hipError_t e = hipLaunchCooperativeKernel((const void*)mk_fwd, dim3(grid), dim3(NWAVES * 64), kargs, LDS_BYTES, stream);
    if (e != hipSuccess) fprintf(stderr, "kernel_launch: cooperative launch failed: %s (grid %d)\n", hipGetErrorString(e), grid);
}
```

```cpp
#include <hip/hip_runtime.h>
#include <hip/hip_cooperative_groups.h>
#include <hip/hip_bf16.h>
#include <cstdio>
#include <cstdint>
#include <cmath>
namespace cg = cooperative_groups;

constexpr int DM = 1024, DFF = 2816;
constexpr int M_P = 2 * 8192, M_S = 8 * 4096, MROWS = M_P + M_S;
constexpr int QOP = 1024;
constexpr int KVP = 1280;
constexpr float RMS_EPS = 1e-6f;
constexpr float LAM_INIT = 0.2f;

namespace pg8 {
#define PG8_LAS __attribute__((address_space(3)))
typedef unsigned short bf16_t;
typedef short bf16x8 __attribute__((ext_vector_type(8)));
typedef float f32x4 __attribute__((ext_vector_type(4)));
typedef unsigned u32x4 __attribute__((ext_vector_type(4)));
typedef unsigned u32x2 __attribute__((ext_vector_type(2)));
constexpr int BM = 256, BK = 64, HALF = 128, HTB = HALF * BK * 2, STAGE_BYTES = 8 * HTB, NXCD = 8, WGM = 8;

__host__ __device__ __forceinline__ int lds_byte(int r, int c) { const int st = (r >> 4) * 2 + (c >> 5), rr = r & 15, cc = c & 31, ob = rr * 64 + cc * 2; return st * 1024 + (ob ^ (((ob >> 9) & 1) << 5)); }
__host__ __device__ __forceinline__ void stage_rc(int b, int& R, int& C) { const int st = b / 1024, sb = b % 1024, swz = sb ^ (((sb >> 9) & 1) << 5); R = (st >> 1) * 16 + swz / 64; C = (st & 1) * 32 + (swz % 64) / 2; }
__host__ __device__ __forceinline__ int perm32(int rho) { const int n = rho >> 4, i = rho & 15; return 8 * (i >> 2) + 4 * n + (i & 3); }

struct Unit { int pm, pn; };
struct Gemm { const bf16_t* A; const bf16_t* Bt; int M, N, K, lda; int kpairA = 256; };

struct StaticOrder {
    int nM, nN, nwg, G, c;
    __host__ __device__ void init(int M, int N, int G_, int c_) { nM = M / BM; nN = N / BM; nwg = nM * nN; G = G_; c = c_; }
    __host__ __device__ bool next(int i, Unit& u) const {
        const long L = (long)i * G + c; if (L >= nwg) return false;
        int wgid = (int)L; { const int q = nwg / NXCD, r = nwg % NXCD, xcd = wgid % NXCD, off = wgid / NXCD; wgid = (xcd < r ? xcd * (q + 1) : r * (q + 1) + (xcd - r) * q) + off; }
        const int nig = WGM * nN, gid = wgid / nig, fm = gid * WGM, gsz = (nM - fm) < WGM ? (nM - fm) : WGM;
        u.pm = fm + ((wgid % nig) % gsz); u.pn = (wgid % nig) / gsz; return true;
    }
};

__device__ __forceinline__ unsigned cvt_pk_bf16(float lo, float hi) { unsigned r; asm volatile("v_cvt_pk_bf16_f32 %0, %1, %2" : "=v"(r) : "v"(lo), "v"(hi)); return r; }
__device__ __forceinline__ float bf_lo(unsigned w) { return __uint_as_float(w << 16); }
__device__ __forceinline__ float bf_hi(unsigned w) { return __uint_as_float(w & 0xffff0000u); }
__device__ __forceinline__ float sigmoidf_(float v) { return __builtin_amdgcn_rcpf(1.0f + __builtin_amdgcn_exp2f(-1.4426950408889634f * v)); }
__device__ __forceinline__ float rstd_of(const float* ssq, int row) {
    const f32x4* p = (const f32x4*)ssq + row; const f32x4 s = (p[0] + p[MROWS]) + (p[2 * MROWS] + p[3 * MROWS]);
    return 1.0f / sqrtf(((s[0] + s[1]) + (s[2] + s[3])) * (1.0f / 1024.0f) + RMS_EPS); }


struct EpiSwiGLU {
    bf16_t* H; const float* ssq;
    __device__ __forceinline__ void operator()(const f32x4 (&acc)[2][2][4][2], const Unit& u, int wr, int wc, int fr, int fq) const {
        const int row0 = u.pm * BM + wr * 64 + fr, colh = u.pn * 128 + wc * 32 + 8 * fq;
#pragma unroll
        for (int ai = 0; ai < 2; ++ai)
#pragma unroll
            for (int m = 0; m < 4; ++m) {
                const int row = row0 + ai * HALF + m * 16;
                const float rs = ssq ? rstd_of(ssq, row) : 1.0f;
                float h[8];
#pragma unroll
                for (int n = 0; n < 2; ++n)
#pragma unroll
                    for (int e = 0; e < 4; ++e) { const float g = acc[ai][0][m][n][e] * rs, uu = acc[ai][1][m][n][e] * rs; h[n * 4 + e] = g * sigmoidf_(g) * uu; }
                u32x4 w; w.x = cvt_pk_bf16(h[0], h[1]); w.y = cvt_pk_bf16(h[2], h[3]); w.z = cvt_pk_bf16(h[4], h[5]); w.w = cvt_pk_bf16(h[6], h[7]);
                *(u32x4*)(H + (size_t)row * DFF + colh) = w;
            }
    }
};
template <int ALPHA2  , bool WX> struct EpiRes {
    const float* xin_p; const float* xin_s; float* out; bf16_t* xn; const float* gn; float* ssq;
    __device__ __forceinline__ void operator()(const f32x4 (&acc)[2][2][4][2], const Unit& u, int wr, int wc, int fr, int fq) const {
        const int row0 = u.pm * BM + wr * 64 + fr, col0 = u.pn * BM + wc * 32 + 8 * fq;
        f32x4 gv[2][2];
        if constexpr (WX) {
#pragma unroll
            for (int bj = 0; bj < 2; ++bj)
#pragma unroll
                for (int n = 0; n < 2; ++n) gv[bj][n] = *(const f32x4*)(gn + col0 + bj * HALF + 4 * n);
        }
#pragma unroll
        for (int ai = 0; ai < 2; ++ai)
#pragma unroll
            for (int m = 0; m < 4; ++m) {
                const int row = row0 + ai * HALF + m * 16;
                const float* xr = (row < M_P) ? xin_p + (size_t)row * DM : xin_s + (size_t)(row - M_P) * DM;
                float* orow = out + (size_t)row * DM;
                float ss = 0.f;
#pragma unroll
                for (int bj = 0; bj < 2; ++bj) {
                    f32x4 o[2];
#pragma unroll
                    for (int n = 0; n < 2; ++n) { const f32x4 xv = *(const f32x4*)(xr + col0 + bj * HALF + 4 * n); o[n] = xv + acc[ai][bj][m][n] * (0.5f * ALPHA2); *(f32x4*)(orow + col0 + bj * HALF + 4 * n) = o[n]; }
                    if constexpr (WX) {
#pragma unroll
                        for (int n = 0; n < 2; ++n) ss += (o[n][0] * o[n][0] + o[n][1] * o[n][1]) + (o[n][2] * o[n][2] + o[n][3] * o[n][3]);
                        const f32x4 a = o[0] * gv[bj][0], b = o[1] * gv[bj][1];
                        u32x4 w; w.x = cvt_pk_bf16(a[0], a[1]); w.y = cvt_pk_bf16(a[2], a[3]); w.z = cvt_pk_bf16(b[0], b[1]); w.w = cvt_pk_bf16(b[2], b[3]);
                        *(u32x4*)(xn + (size_t)row * DM + col0 + bj * HALF) = w;
                    }
                }
                if constexpr (WX) { ss += __shfl_xor(ss, 16); ss += __shfl_xor(ss, 32); if (fq == 0) ssq[((size_t)u.pn * MROWS + row) * 4 + wc] = ss; }
            }
    }
};
struct EpiInProjPrep {
    bf16_t* QO; bf16_t* KV; const float* ssq; const float* rope; const float* gaq; const float* gak; const float* gbq; const float* gbk;
    __device__ __forceinline__ void operator()(const f32x4 (&acc)[2][2][4][2], const Unit& u, int wr, int wc, int fr, int fq) const {
        const int row0 = u.pm * BM + wr * 64 + fr;
        int type; const float* gain; bf16_t* base; int pitch; float scale = 1.0f;
        if (u.pn < 4) { base = QO + u.pn * BM + wc * 64; pitch = QOP; scale = 0.125f * 1.4426950408889634f; if (u.pn < 2) { type = 1; gain = gaq; } else { type = 2; gain = gbq; } }
        else { base = KV + (u.pn - 4) * BM + wc * 64; pitch = KVP; gain = gbk;
               if (u.pn == 4) { type = (wc < 2) ? 1 : 0; gain = gak; } else if (u.pn < 7) { type = 2; } else { type = 0; } }
        base += 8 * fq;
        f32x4 g[4];
#pragma unroll
        for (int q = 0; q < 4; ++q) g[q] = *(const f32x4*)(gain + (q >> 1) * 32 + 8 * fq + (q & 1) * 4);
#pragma unroll
        for (int ai = 0; ai < 2; ++ai)
#pragma unroll
            for (int m = 0; m < 4; ++m) {
                const int row = row0 + ai * HALF + m * 16;
                const float rs = rstd_of(ssq, row);
                float lo[8], hi[8];
#pragma unroll
                for (int n = 0; n < 2; ++n)
#pragma unroll
                    for (int e = 0; e < 4; ++e) { lo[4 * n + e] = acc[ai][0][m][n][e] * rs; hi[4 * n + e] = acc[ai][1][m][n][e] * rs; }
                if (type != 0) {
                    float ss = 0.f;
#pragma unroll
                    for (int k = 0; k < 8; ++k) ss += lo[k] * lo[k] + hi[k] * hi[k];
                    ss += __shfl_xor(ss, 16); ss += __shfl_xor(ss, 32);
                    const float rn = 1.0f / sqrtf(ss * (1.0f / 64.0f) + RMS_EPS);
#pragma unroll
                    for (int k = 0; k < 8; ++k) { lo[k] *= rn * g[k >> 2][k & 3]; hi[k] *= rn * g[2 + (k >> 2)][k & 3]; }
                    const int t = (row < M_P) ? (row & 8191) : ((row - M_P) & 4095);
                    const f32x4* rp = (const f32x4*)(rope + ((size_t)t * 40 + (type == 1 ? 8 * fq : 32)) * 2);
                    const f32x4 c01 = rp[0], c23 = rp[1], c45 = rp[2], c67 = rp[3];
                    const float cs[16] = {c01[0], c01[1], c01[2], c01[3], c23[0], c23[1], c23[2], c23[3], c45[0], c45[1], c45[2], c45[3], c67[0], c67[1], c67[2], c67[3]};
                    if (type == 1) {
#pragma unroll
                        for (int k = 0; k < 8; ++k) { const float a = lo[k], b = hi[k]; lo[k] = a * cs[2 * k] - b * cs[2 * k + 1]; hi[k] = b * cs[2 * k] + a * cs[2 * k + 1]; }
                    } else {
#pragma unroll
                        for (int k = 0; k < 8; ++k) { const float p = __shfl_xor(lo[k], 16); const float r = (fq == 0) ? lo[k] * cs[2 * k] - p * cs[2 * k + 1] : lo[k] * cs[2 * k] + p * cs[2 * k + 1]; lo[k] = (fq < 2) ? r : lo[k]; }
                    }
#pragma unroll
                    for (int k = 0; k < 8; ++k) { lo[k] *= scale; hi[k] *= scale; }
                }
                u32x4 w0, w1;
                w0.x = cvt_pk_bf16(lo[0], lo[1]); w0.y = cvt_pk_bf16(lo[2], lo[3]); w0.z = cvt_pk_bf16(lo[4], lo[5]); w0.w = cvt_pk_bf16(lo[6], lo[7]);
                w1.x = cvt_pk_bf16(hi[0], hi[1]); w1.y = cvt_pk_bf16(hi[2], hi[3]); w1.z = cvt_pk_bf16(hi[4], hi[5]); w1.w = cvt_pk_bf16(hi[6], hi[7]);
                *(u32x4*)(base + (size_t)row * pitch) = w0; *(u32x4*)(base + (size_t)row * pitch + 32) = w1;
            }
    }
};
struct EpiGate {
    bf16_t* G; const float* ssq;
    __device__ __forceinline__ void operator()(const f32x4 (&acc)[2][2][4][2], const Unit& u, int wr, int wc, int fr, int fq) const {
        const int row0 = u.pm * BM + wr * 64 + fr;
        bf16_t* base = G + u.pn * BM + wc * 32 + 8 * fq;
#pragma unroll
        for (int ai = 0; ai < 2; ++ai)
#pragma unroll
            for (int m = 0; m < 4; ++m) {
                const int row = row0 + ai * HALF + m * 16;
                const float rs = rstd_of(ssq, row);
#pragma unroll
                for (int bj = 0; bj < 2; ++bj) {
                    float v[8];
#pragma unroll
                    for (int n = 0; n < 2; ++n)
#pragma unroll
                        for (int e = 0; e < 4; ++e) v[n * 4 + e] = acc[ai][bj][m][n][e] * rs;
                    u32x4 w; w.x = cvt_pk_bf16(v[0], v[1]); w.y = cvt_pk_bf16(v[2], v[3]); w.z = cvt_pk_bf16(v[4], v[5]); w.w = cvt_pk_bf16(v[6], v[7]);
                    *(u32x4*)(base + (size_t)row * 2048 + bj * HALF) = w;
                }
            }
    }
};
struct EpiMerge {
    const bf16_t* G; bf16_t* T;
    __device__ __forceinline__ void operator()(const f32x4 (&acc)[2][2][4][2], const Unit& u, int wr, int wc, int fr, int fq) const {
        const int row0 = u.pm * BM + wr * 64 + fr;
        const bf16_t* gb_ = G + u.pn * BM + wc * 32 + 8 * fq;
        bf16_t* tb = T + u.pn * BM + wc * 32 + 8 * fq;
#pragma unroll
        for (int ai = 0; ai < 2; ++ai)
#pragma unroll
            for (int m = 0; m < 4; ++m) {
                const int row = row0 + ai * HALF + m * 16;
                const u32x4 ga = *(const u32x4*)(gb_ + (size_t)row * 2048), gb = *(const u32x4*)(gb_ + (size_t)row * 2048 + HALF);
                const f32x4 a0 = acc[ai][0][m][0], a1 = acc[ai][0][m][1], b0 = acc[ai][1][m][0], b1 = acc[ai][1][m][1];
                float t[8];
                t[0] = sigmoidf_(bf_lo(ga.x)) * a0[0] + sigmoidf_(bf_lo(gb.x)) * b0[0]; t[1] = sigmoidf_(bf_hi(ga.x)) * a0[1] + sigmoidf_(bf_hi(gb.x)) * b0[1];
                t[2] = sigmoidf_(bf_lo(ga.y)) * a0[2] + sigmoidf_(bf_lo(gb.y)) * b0[2]; t[3] = sigmoidf_(bf_hi(ga.y)) * a0[3] + sigmoidf_(bf_hi(gb.y)) * b0[3];
                t[4] = sigmoidf_(bf_lo(ga.z)) * a1[0] + sigmoidf_(bf_lo(gb.z)) * b1[0]; t[5] = sigmoidf_(bf_hi(ga.z)) * a1[1] + sigmoidf_(bf_hi(gb.z)) * b1[1];
                t[6] = sigmoidf_(bf_lo(ga.w)) * a1[2] + sigmoidf_(bf_lo(gb.w)) * b1[2]; t[7] = sigmoidf_(bf_hi(ga.w)) * a1[3] + sigmoidf_(bf_hi(gb.w)) * b1[3];
                u32x4 w; w.x = cvt_pk_bf16(t[0], t[1]); w.y = cvt_pk_bf16(t[2], t[3]); w.z = cvt_pk_bf16(t[4], t[5]); w.w = cvt_pk_bf16(t[6], t[7]);
                *(u32x4*)(tb + (size_t)row * 2048) = w;
            }
    }
};

template <class Epi, bool ALIGN_EPI = true, bool BLOCKDIAG = false>
__device__ __forceinline__ void gemm_phase(PG8_LAS unsigned char* lds, const Gemm g, const StaticOrder& S, const Epi& E) {
    int tid_ = threadIdx.x; asm volatile("" : "+v"(tid_));
    const int tid = tid_, wid = __builtin_amdgcn_readfirstlane(tid >> 6), lane = tid & 63, wr = wid >> 2, wc = wid & 3, fr = lane & 15, fq = lane >> 4;
    const int K = g.K, nt = K / BK;
    unsigned voffA[2], voffB[2];
#pragma unroll
    for (int i = 0; i < 2; ++i) { int R, C; stage_rc(tid * 16 + i * 8192, R, C); const int Rb = (R & ~31) + perm32(R & 31);
        voffA[i] = (unsigned)(R * g.lda + C) * 2u; voffB[i] = (unsigned)(Rb * K + C) * 2u; }
    const size_t kstep = (size_t)(BK * 2);
    const size_t hstepA = (size_t)HALF * g.lda * 2, tstepA = 2 * hstepA;
    const size_t hstepB = (size_t)HALF * K * 2, tstepB = 2 * hstepB;
    const unsigned ldsw = (unsigned)wid * 1024u;
    const int aoff = lds_byte(wr * 64 + fr, fq * 8), boff = lds_byte(wc * 32 + fr, fq * 8);
#define PG8_SA(b, h) (((b) * 2 + (h)) * HTB)
#define PG8_SB(b, h) ((4 + (b) * 2 + (h)) * HTB)
#define PG8_STAGE(bufoff, gbase, voff) do { _Pragma("unroll") for (int _i = 0; _i < 2; ++_i) \
        __builtin_amdgcn_global_load_lds((const unsigned*)((const char*)(gbase) + (voff)[_i]), (PG8_LAS unsigned*)(lds + (bufoff) + ldsw + _i * 8192), 16, 0, 0); } while (0)
#define PG8_LDA(dst, b, h) do { _Pragma("unroll") for (int m = 0; m < 4; ++m) _Pragma("unroll") for (int k = 0; k < 2; ++k) dst[m][k] = *(const PG8_LAS bf16x8*)(lds + PG8_SA(b, h) + aoff + m * 2048 + k * 1024); } while (0)
#define PG8_LDB(dst, b, h) do { _Pragma("unroll") for (int n = 0; n < 2; ++n) _Pragma("unroll") for (int k = 0; k < 2; ++k) dst[n][k] = *(const PG8_LAS bf16x8*)(lds + PG8_SB(b, h) + boff + n * 2048 + k * 1024); } while (0)
#define PG8_MMA(ai, bj, At, Bt) do { __builtin_amdgcn_s_setprio(1); _Pragma("unroll") for (int m = 0; m < 4; ++m) _Pragma("unroll") for (int n = 0; n < 2; ++n) _Pragma("unroll") for (int k = 0; k < 2; ++k) \
        acc[ai][bj][m][n] = __builtin_amdgcn_mfma_f32_16x16x32_bf16(Bt[n][k], At[m][k], acc[ai][bj][m][n], 0, 0, 0); __builtin_amdgcn_s_setprio(0); } while (0)
#define PG8_WAIT_V(n) asm volatile("s_waitcnt vmcnt(" #n ")" ::: "memory")
#define PG8_WAIT_L(n) asm volatile("s_waitcnt lgkmcnt(" #n ")" ::: "memory")
#define PG8_BAR __builtin_amdgcn_s_barrier()
#define PG8_SCHED __builtin_amdgcn_sched_barrier(0)
#define PG8_MM2(ai, SEL) do { if constexpr ((SEL) != 1) { PG8_MMA(ai, 0, At, B0); } if constexpr ((SEL) != 0) { PG8_MMA(ai, 1, At, B1); } } while (0)
#define PG8_LDB2(b, SEL) do { if constexpr ((SEL) != 1) { PG8_LDB(B0, b, 0); } if constexpr ((SEL) != 0) { PG8_LDB(B1, b, 1); } } while (0)
#define PG8_KLOOP(T0, T1, SEL) for (int t = (T0); t < (T1); t += 2) { \
            const bool last = (t == nt - 2); \
            const char* a1 = cA + (size_t)(t >> 1) * g.kpairA + kstep; \
            const char* a2 = last ? nA : cA + (size_t)((t >> 1) + 1) * g.kpairA; const char* b2 = last ? nB : cB + (size_t)(t + 2) * kstep; \
            const char* a3 = a2 + kstep; const char* b3 = b2 + kstep; \
            PG8_LDB2(0, SEL); PG8_SCHED; PG8_LDA(At, 0, 0); PG8_STAGE(PG8_SA(1, 1), a1 + hstepA, voffA); \
            PG8_WAIT_V(8); PG8_WAIT_L(0); PG8_BAR; PG8_MM2(0, SEL); PG8_BAR; PG8_SCHED; \
            PG8_LDA(At, 0, 1); PG8_STAGE(PG8_SB(0, 0), b2, voffB); PG8_STAGE(PG8_SB(0, 1), b2 + hstepB, voffB); PG8_STAGE(PG8_SA(0, 0), a2, voffA); \
            PG8_WAIT_V(8); PG8_WAIT_L(0); PG8_BAR; PG8_MM2(1, SEL); PG8_BAR; PG8_SCHED; \
            PG8_LDB2(1, SEL); PG8_SCHED; PG8_LDA(At, 1, 0); PG8_STAGE(PG8_SA(0, 1), a2 + hstepA, voffA); \
            PG8_WAIT_V(8); PG8_WAIT_L(0); PG8_BAR; PG8_MM2(0, SEL); PG8_BAR; PG8_SCHED; \
            PG8_LDA(At, 1, 1); PG8_STAGE(PG8_SB(1, 0), b3, voffB); PG8_STAGE(PG8_SB(1, 1), b3 + hstepB, voffB); PG8_STAGE(PG8_SA(1, 0), a3, voffA); \
            PG8_WAIT_V(8); PG8_WAIT_L(0); PG8_BAR; PG8_MM2(1, SEL); PG8_BAR; PG8_SCHED; \
 \
        }
    Unit cur, nxt; int ui = 0;
    if (!S.next(0, cur)) return;
    f32x4 acc[2][2][4][2];
#pragma unroll
    for (int a = 0; a < 2; ++a)
#pragma unroll
        for (int b = 0; b < 2; ++b)
#pragma unroll
            for (int m = 0; m < 4; ++m)
#pragma unroll
                for (int n = 0; n < 2; ++n) acc[a][b][m][n] = (f32x4){0.f, 0.f, 0.f, 0.f};
    bf16x8 At[4][2], B0[2][2], B1[2][2];
    const char* cA = (const char*)g.A + (size_t)cur.pm * tstepA; const char* cB = (const char*)g.Bt + (size_t)cur.pn * tstepB;
    PG8_STAGE(PG8_SB(0, 0), cB, voffB); PG8_STAGE(PG8_SB(0, 1), cB + hstepB, voffB); PG8_STAGE(PG8_SA(0, 0), cA, voffA); PG8_STAGE(PG8_SA(0, 1), cA + hstepA, voffA);
    if (wr == 1) PG8_BAR;
    PG8_WAIT_V(2); PG8_BAR;
    PG8_STAGE(PG8_SB(1, 0), cB + kstep, voffB); PG8_STAGE(PG8_SA(1, 0), cA + kstep, voffA); PG8_STAGE(PG8_SB(1, 1), cB + hstepB + kstep, voffB);
    PG8_WAIT_V(6); PG8_BAR;
    for (;;) {
        const bool has_next = S.next(ui + 1, nxt);
        const char* nA = has_next ? (const char*)g.A + (size_t)nxt.pm * tstepA : cA; const char* nB = has_next ? (const char*)g.Bt + (size_t)nxt.pn * tstepB : cB;
        if constexpr (BLOCKDIAG) { PG8_KLOOP(0, nt / 2, 0) PG8_KLOOP(nt / 2, nt, 1) } else { PG8_KLOOP(0, nt, 2) }
        if constexpr (ALIGN_EPI) { if (wr == 0) PG8_BAR; }
        E(acc, cur, wr, wc, fr, fq);
        if (!has_next) break;
#pragma unroll
        for (int a = 0; a < 2; ++a)
#pragma unroll
            for (int b = 0; b < 2; ++b)
#pragma unroll
                for (int m = 0; m < 4; ++m)
#pragma unroll
                    for (int n = 0; n < 2; ++n) acc[a][b][m][n] = (f32x4){0.f, 0.f, 0.f, 0.f};
        cur = nxt; cA = nA; cB = nB; ++ui;
        if constexpr (ALIGN_EPI) { if (wr == 1) PG8_BAR; }
    }
    PG8_WAIT_V(0);
    if constexpr (!ALIGN_EPI) { if (wr == 0) PG8_BAR; }
    PG8_BAR;
#undef PG8_SA
#undef PG8_SB
#undef PG8_STAGE
#undef PG8_LDA
#undef PG8_LDB
#undef PG8_MMA
#undef PG8_WAIT_V
#undef PG8_WAIT_L
#undef PG8_BAR
#undef PG8_SCHED
#undef PG8_MM2
#undef PG8_LDB2
#undef PG8_KLOOP
}
}

namespace attn_body {
using bf16=__hip_bfloat16;
using bf16x8=__attribute__((ext_vector_type(8)))short;
using s16x4=__attribute__((ext_vector_type(4)))short;
using f32x16=__attribute__((ext_vector_type(16)))float;
using u32x4=__attribute__((ext_vector_type(4)))unsigned;
constexpr int D=64;
constexpr int NW=8,QBLK=32,QB=QBLK*NW,KVBLK=64;
__device__ __forceinline__ int crow(int r,int hi){return (r&3)+8*(r>>2)+4*hi;}
#define SBAR() __builtin_amdgcn_sched_barrier(0)
constexpr int NSLOT=3, SLOTB=8192;
constexpr int LDS_K=0, LDS_V=NSLOT*SLOTB, LDS_WS=2*NSLOT*SLOTB, LDS_OST=LDS_WS+NW*64*4, LDS_BYTES=LDS_OST+NW*4096;
constexpr float C2=0.125f*1.4426950408889634f;
__device__ __forceinline__ void glds16(const void*gsrc,unsigned lds_dst){unsigned keep;
  asm volatile("s_mov_b32 %0, m0\n\ts_mov_b32 m0, %2\n\ts_nop 0\n\tglobal_load_lds_dwordx4 %1, off\n\ts_mov_b32 m0, %0":"=&s"(keep):"v"(gsrc),"s"(lds_dst):"memory");}
__device__ __forceinline__ float max3f(float a,float b,float c){float r;asm("v_max3_f32 %0, %1, %2, %3":"=v"(r):"v"(a),"v"(b),"v"(c));return r;}
__device__ __forceinline__ float max2f(float a,float b){float r;asm("v_max_f32_e32 %0, %1, %2":"=v"(r):"v"(a),"v"(b));return r;}
__device__ __forceinline__ float fadd_s(float a,float b){float r;asm("v_add_f32_e32 %0, %1, %2":"=v"(r):"v"(a),"v"(b));return r;}
__device__ __forceinline__ float fsub_s(float a,float b){float r;asm("v_sub_f32_e32 %0, %1, %2":"=v"(r):"v"(a),"v"(b));return r;}
typedef float f32x2_t __attribute__((ext_vector_type(2))); typedef __bf16 bf16x2_t __attribute__((ext_vector_type(2)));
__device__ __forceinline__ unsigned cvtpk_s(float lo,float hi){f32x2_t v={lo,hi};bf16x2_t b=__builtin_convertvector(v,bf16x2_t);return __builtin_bit_cast(unsigned,b);}
#define WAIT_BAR(N) asm volatile("s_waitcnt vmcnt(" #N ") lgkmcnt(0)\n\ts_barrier":::"memory")

__device__ __forceinline__ void qkt(f32x16&p0,f32x16&p1,const char*Kslot,const bf16x8*qr,const f32x16&negm,int r32,int hi){
  const char*kb=Kslot+hi*1024+r32*16;
  #pragma unroll
  for(int d0=0;d0<4;++d0){
    const bf16x8 b0=*reinterpret_cast<const bf16x8*>(kb+d0*2048);
    const bf16x8 b1=*reinterpret_cast<const bf16x8*>(kb+d0*2048+512);
    if(d0==0){p0=__builtin_amdgcn_mfma_f32_32x32x16_bf16(b0,qr[0],negm,0,0,0);p1=__builtin_amdgcn_mfma_f32_32x32x16_bf16(b1,qr[0],negm,0,0,0);}
    else{p0=__builtin_amdgcn_mfma_f32_32x32x16_bf16(b0,qr[d0],p0,0,0,0);p1=__builtin_amdgcn_mfma_f32_32x32x16_bf16(b1,qr[d0],p1,0,0,0);}}
}
typedef __attribute__((address_space(3))) const char* lds_cptr;
typedef short v4i16_t __attribute__((ext_vector_type(4)));
__device__ __forceinline__ void kload8(bf16x8*kf,lds_cptr kp){
  kf[0]=*(const __attribute__((address_space(3))) bf16x8*)(kp);      kf[1]=*(const __attribute__((address_space(3))) bf16x8*)(kp+512);
  kf[2]=*(const __attribute__((address_space(3))) bf16x8*)(kp+2048); kf[3]=*(const __attribute__((address_space(3))) bf16x8*)(kp+2560);
  kf[4]=*(const __attribute__((address_space(3))) bf16x8*)(kp+4096); kf[5]=*(const __attribute__((address_space(3))) bf16x8*)(kp+4608);
  kf[6]=*(const __attribute__((address_space(3))) bf16x8*)(kp+6144); kf[7]=*(const __attribute__((address_space(3))) bf16x8*)(kp+6656);
}
__device__ __forceinline__ void kload2(bf16x8*kf,lds_cptr kp,int j){ kf[2*j]=*(const __attribute__((address_space(3))) bf16x8*)(kp+j*2048); kf[2*j+1]=*(const __attribute__((address_space(3))) bf16x8*)(kp+j*2048+512); }
__device__ __forceinline__ s16x4 vtr(lds_cptr p){ return __builtin_bit_cast(s16x4,__builtin_amdgcn_ds_read_tr16_b64_v4i16((__attribute__((address_space(3))) v4i16_t*)p)); }
__device__ __forceinline__ float rowmax(const f32x16&p0,const f32x16&p1){
  float a=max3f(p0[0],p0[1],p1[0]),b=max3f(p0[2],p0[3],p1[1]);a=max3f(a,p1[2],p1[3]);
  #pragma unroll
  for(int r=4;r<16;r+=4){a=max3f(a,p0[r],p0[r+1]);b=max3f(b,p0[r+2],p0[r+3]);a=max3f(a,p1[r],p1[r+1]);b=max3f(b,p1[r+2],p1[r+3]);}
  const float m=max2f(a,b);
  auto rr=__builtin_amdgcn_permlane32_swap(__float_as_uint(m),__float_as_uint(m),false,false);
  return max2f(__uint_as_float(rr[0]),__uint_as_float(rr[1]));
}
__device__ __forceinline__ void pv(f32x16*o,int vb,bf16x8 pa0,bf16x8 pa1,bf16x8 pa2,bf16x8 pa3){
  #pragma unroll
  for(int d0=0;d0<2;++d0){s16x4 lo[4],hi[4];
    #pragma unroll
    for(int ks=0;ks<4;++ks){
      asm volatile("ds_read_b64_tr_b16 %0,%1 offset:%c2":"=&v"(lo[ks]):"v"(vb),"i"(d0*4096+ks*1024):"memory");
      asm volatile("ds_read_b64_tr_b16 %0,%1 offset:%c2":"=&v"(hi[ks]):"v"(vb),"i"(d0*4096+ks*1024+512):"memory");}
    asm volatile("s_waitcnt lgkmcnt(0)":::"memory");SBAR();
    #define PK(k) (bf16x8){lo[k][0],lo[k][1],lo[k][2],lo[k][3],hi[k][0],hi[k][1],hi[k][2],hi[k][3]}
    o[d0]=__builtin_amdgcn_mfma_f32_32x32x16_bf16(pa0,PK(0),o[d0],0,0,0);
    o[d0]=__builtin_amdgcn_mfma_f32_32x32x16_bf16(pa1,PK(1),o[d0],0,0,0);
    o[d0]=__builtin_amdgcn_mfma_f32_32x32x16_bf16(pa2,PK(2),o[d0],0,0,0);
    o[d0]=__builtin_amdgcn_mfma_f32_32x32x16_bf16(pa3,PK(3),o[d0],0,0,0);
    #undef PK
  }
}

template<int THRL,int VM,bool NOMAX> __device__ __forceinline__ void attn_unit(const bf16*Qb,const bf16*__restrict__ Kh,const bf16*__restrict__ Vh,bf16*Ob,const int NT,const int sp,float*wscr,char*shm){
  int tid_=threadIdx.x; asm volatile("":"+v"(tid_));
  const int tid=tid_,lane=tid&63,r32=lane&31,hi=lane>>5; const int wid=__builtin_amdgcn_readfirstlane(tid>>6);
  const bf16*Qw=Qb+(long)(wid*QBLK)*QOP;
  const unsigned lds0=(unsigned)(uintptr_t)shm;
  constexpr int LDS_WS_=LDS_V+3*VM*SLOTB, LDS_OST_=LDS_WS_+NW*64*4;
  float*wsf=(float*)(shm+LDS_WS_)+wid*64;
  const bf16*ksrc=Kh+(long)lane*KVP+wid*8;
  const bf16*vsrc=Vh+(long)(16*(wid&3)+(lane>>2))*KVP+(wid>>2)*32+(lane&3)*8;
  const unsigned kdst=lds0+LDS_K+wid*1024, vdst=lds0+LDS_V+wid*1024;
  #define DMA_K(t,slot) glds16(ksrc+(long)(t)*KVBLK*KVP,(unsigned)__builtin_amdgcn_readfirstlane(kdst+(slot)))
  #define DMA_V(t,slot) do{ glds16(vsrc+(long)(t)*KVBLK*KVP,(unsigned)__builtin_amdgcn_readfirstlane(vdst+VM*(slot))); if constexpr(VM==2) glds16(vsrc+64+(long)(t)*KVBLK*KVP,(unsigned)__builtin_amdgcn_readfirstlane(vdst+VM*(slot)+8192)); }while(0)
  const int vb0=(int)(lds0+LDS_V)+((lane>>4)&1)*32+(lane&3)*8+(4*hi+((lane&15)>>2))*64;
  const char*Kbase=shm+LDS_K; bf16x8 kf[8];
  const lds_cptr shm3=(lds_cptr)shm; const lds_cptr kp0=shm3+LDS_K+hi*1024+r32*16; const lds_cptr vp0=shm3+LDS_V+((lane>>4)&1)*32+(lane&3)*8+(4*hi+((lane&15)>>2))*64;
  if(wid>=4)__builtin_amdgcn_s_setprio(1);
  DMA_K(0,0);DMA_V(0,0);DMA_K(1,SLOTB);
  bf16x8 qr[4];
  #pragma unroll
  for(int d0=0;d0<4;++d0)qr[d0]=*reinterpret_cast<const bf16x8*>(&Qw[(long)r32*QOP+d0*16+hi*8]);
  const lds_cptr qpk=shm3+LDS_OST_+wid*4096+lane*16;
  if constexpr(VM==2){
    #pragma unroll
    for(int d0=0;d0<4;++d0)*(__attribute__((address_space(3))) bf16x8*)(const_cast<__attribute__((address_space(3))) char*>(qpk)+d0*1024)=qr[d0]; }
  float mhat=0.f,l_reg=0.f;f32x16 o[2*VM];
  #pragma unroll
  for(int d_=0;d_<2*VM;++d_)o[d_]=f32x16{};
 f32x16 negm=f32x16{}; if constexpr(VM==1){asm volatile("":"+v"(negm));}
  bool resc=false;
  #define START(P0,P1) do{ resc=false; if constexpr(!NOMAX) { const float rm=rowmax(P0,P1); const float dl=rm; mhat=fadd_s(mhat,dl); \
      _Pragma("unroll") for(int r=0;r<16;++r){P0[r]=fsub_s(P0[r],dl);P1[r]=fsub_s(P1[r],dl);} \
      if constexpr(VM==1){ _Pragma("unroll") for(int r=0;r<16;++r)negm[r]=-mhat; asm volatile("":"+v"(negm)); } } \
    _Pragma("unroll") for(int r=0;r<16;++r)P0[r]=__builtin_amdgcn_exp2f(P0[r]); }while(0)
  #define RESC() do{ if(!NOMAX&&resc){ asm volatile("s_waitcnt lgkmcnt(0)":::"memory"); \
      _Pragma("unroll") for(int d_=0;d_<2*VM;++d_) _Pragma("unroll") for(int r=0;r<16;++r)o[d_][r]*=wsf[crow(r,hi)]; } }while(0)
  f32x16 pA0,pA1,pB0,pB1;
  int sl_prev=0,sl_cur=0,sl_next=SLOTB;
  #define ROT() do{sl_prev=sl_cur;sl_cur=sl_next;sl_next=(sl_next==(NSLOT-1)*SLOTB)?0:sl_next+SLOTB;}while(0)
  DMA_K(2,2*SLOTB);
  WAIT_BAR(3);
  qkt(pA0,pA1,Kbase,qr,negm,r32,hi);asm volatile("s_nop 15\n\ts_nop 7":"+v"(pA0),"+v"(pA1));
  START(pA0,pA1);
  _Pragma("unroll") for(int r=0;r<16;++r)pA1[r]=__builtin_amdgcn_exp2f(pA1[r]);
  WAIT_BAR(0);
  DMA_K(3,0);DMA_V(1,SLOTB);
  ROT();
  kload8(kf,kp0+sl_cur);
  if constexpr(VM==2){WAIT_BAR(3);}else{WAIT_BAR(2);}
  s16x4 vlo[8],vhi[8]; u32x4 pw0,pw1,pw2,pw3;
  #define PKW(P,B) cvtpk_s(P[B],P[B+1])
  #define PAF(k) __builtin_bit_cast(bf16x8,pw##k)
  #define VFR(i) (bf16x8){vlo[i][0],vlo[i][1],vlo[i][2],vlo[i][3],vhi[i][0],vhi[i][1],vhi[i][2],vhi[i][3]}
  #define PIN(x) asm volatile("":"+v"(x))
  #define MX3(a,b,c) __builtin_fmaxf(__builtin_fmaxf((a),(b)),(c))
  #define GAPA(MF,A0,A1,A2,A3,W0,W1,PW) do{ MF; sacc+=A0; sacc+=A1; sacc+=A2; sacc+=A3; PIN(sacc); W0; W1; PIN(PW); SBAR(); }while(0)
  #define EX(v) __builtin_amdgcn_exp2f(v)
  #define GAPB(MF,X,B,Y,D,KF) do{ MF; if constexpr(VM==2){ vlo[KF]=vtr(vp_+8192+(((KF)>>2)*4096+((KF)&3)*1024)); vhi[KF]=vtr(vp_+8192+(((KF)>>2)*4096+((KF)&3)*1024+512)); if constexpr(NOMAX){ Y[D]=EX(Y[D]); Y[D+1]=EX(Y[D+1]); } else { Y[D]=EX(Y[D]-mhat); Y[D+1]=EX(Y[D+1]-mhat); } PIN(Y); } else { X[B]=EX(X[B]); X[B+1]=EX(X[B+1]); X[B+2]=EX(X[B+2]); X[B+3]=EX(X[B+3]); PIN(X); } SBAR(); }while(0)
  #define VRD(i) do{ vlo[i]=vtr(vp_+(((i)>>2)*4096+((i)&3)*1024)); vhi[i]=vtr(vp_+(((i)>>2)*4096+((i)&3)*1024+512)); }while(0)
  #define KRD(G,j) do{ if(G){ kload2(kf,kp0+sl_next,j); SBAR(); } }while(0)
  #define QR(i) (VM==2? *(const __attribute__((address_space(3))) bf16x8*)(qpk+(i)*1024) : qr[i])
  #define CINIT ((VM==2||NOMAX)?f32x16{}:negm)
  #define STEP(C0,C1,P0,P1,t,GK,GV,GL) do{ SBAR(); \
    const lds_cptr vp_=vp0+VM*sl_prev; \
    VRD(0); SBAR(); float sacc=(P0[0]+P0[1]); \
    GAPA(C0=__builtin_amdgcn_mfma_f32_32x32x16_bf16(kf[0],QR(0),CINIT,0,0,0), P0[2],P0[3],P0[4],P0[5],     pw0[0]=PKW(P0,0), pw0[1]=PKW(P0,2), pw0); \
    VRD(4); SBAR(); GAPA(C1=__builtin_amdgcn_mfma_f32_32x32x16_bf16(kf[1],QR(0),CINIT,0,0,0), P0[6],P0[7],P0[8],P0[9],     pw0[2]=PKW(P0,4), pw0[3]=PKW(P0,6), pw0); \
    VRD(1); SBAR(); GAPA(C0=__builtin_amdgcn_mfma_f32_32x32x16_bf16(kf[2],QR(1),C0,0,0,0),   P0[10],P0[11],P0[12],P0[13], pw1[0]=PKW(P0,8), pw1[1]=PKW(P0,10), pw1); \
    VRD(5); SBAR(); GAPA(C1=__builtin_amdgcn_mfma_f32_32x32x16_bf16(kf[3],QR(1),C1,0,0,0),   P0[14],P0[15],P1[0],P1[1],   pw1[2]=PKW(P0,12),pw1[3]=PKW(P0,14), pw1); \
    VRD(2); SBAR(); GAPA(C0=__builtin_amdgcn_mfma_f32_32x32x16_bf16(kf[4],QR(2),C0,0,0,0),   P1[2],P1[3],P1[4],P1[5],     pw2[0]=PKW(P1,0), pw2[1]=PKW(P1,2), pw2); \
    VRD(6); SBAR(); GAPA(C1=__builtin_amdgcn_mfma_f32_32x32x16_bf16(kf[5],QR(2),C1,0,0,0),   P1[6],P1[7],P1[8],P1[9],     pw2[2]=PKW(P1,4), pw2[3]=PKW(P1,6), pw2); \
    VRD(3); SBAR(); GAPA(C0=__builtin_amdgcn_mfma_f32_32x32x16_bf16(kf[6],QR(3),C0,0,0,0),   P1[10],P1[11],P1[12],P1[13], pw3[0]=PKW(P1,8), pw3[1]=PKW(P1,10), pw3); \
    VRD(7); SBAR(); GAPA(C1=__builtin_amdgcn_mfma_f32_32x32x16_bf16(kf[7],QR(3),C1,0,0,0),   P1[14],P1[15],0.f,0.f,       pw3[2]=PKW(P1,12),pw3[3]=PKW(P1,14), pw3); \
    l_reg+=sacc; \
    if(GK){DMA_K((t)+3,sl_cur);} if(GV){DMA_V((t)+1,sl_next);} \
    if constexpr(!NOMAX) { float a=MX3(C0[0],C0[1],C1[0]),b=MX3(C0[2],C0[3],C1[1]); a=MX3(a,C1[2],C1[3]); \
      _Pragma("unroll") for(int r=4;r<16;r+=4){a=MX3(a,C0[r],C0[r+1]);b=MX3(b,C0[r+2],C0[r+3]);a=MX3(a,C1[r],C1[r+1]);b=MX3(b,C1[r+2],C1[r+3]);} \
      float rm=__builtin_fmaxf(a,b); { auto rr=__builtin_amdgcn_permlane32_swap(__float_as_uint(rm),__float_as_uint(rm),false,false); rm=__builtin_fmaxf(__uint_as_float(rr[0]),__uint_as_float(rr[1])); } \
      resc=false; if constexpr(VM==2) rm-=mhat; \
      if(__builtin_expect(__any(rm>(float)THRL),0)){ const float dl=__builtin_fmaxf(rm,0.f); mhat+=dl; \
        if constexpr(VM==1){ _Pragma("unroll") for(int r=0;r<16;++r){C0[r]-=dl;C1[r]-=dl;} \
        _Pragma("unroll") for(int r=0;r<16;++r)negm[r]=-mhat; asm volatile("":"+v"(negm)); } \
        const float f=__builtin_amdgcn_exp2f(-dl); l_reg*=f; if(hi==0)wsf[r32]=f; resc=true; } } \
    SBAR(); \
    GAPB(o[0]=__builtin_amdgcn_mfma_f32_32x32x16_bf16(PAF(0),VFR(0),o[0],0,0,0), C0,0, C0,0, 0); \
    GAPB(o[1]=__builtin_amdgcn_mfma_f32_32x32x16_bf16(PAF(0),VFR(4),o[1],0,0,0), C0,4, C0,2, 4); \
    KRD(GL,0); GAPB(o[0]=__builtin_amdgcn_mfma_f32_32x32x16_bf16(PAF(1),VFR(1),o[0],0,0,0), C0,8, C0,4, 1); \
    KRD(GL,1); GAPB(o[1]=__builtin_amdgcn_mfma_f32_32x32x16_bf16(PAF(1),VFR(5),o[1],0,0,0), C0,12, C0,6, 5); \
    KRD(GL,2); GAPB(o[0]=__builtin_amdgcn_mfma_f32_32x32x16_bf16(PAF(2),VFR(2),o[0],0,0,0), C1,0, C0,8, 2); \
    KRD(GL,3); GAPB(o[1]=__builtin_amdgcn_mfma_f32_32x32x16_bf16(PAF(2),VFR(6),o[1],0,0,0), C1,4, C0,10, 6); \
    GAPB(o[0]=__builtin_amdgcn_mfma_f32_32x32x16_bf16(PAF(3),VFR(3),o[0],0,0,0), C1,8, C0,12, 3); \
    GAPB(o[1]=__builtin_amdgcn_mfma_f32_32x32x16_bf16(PAF(3),VFR(7),o[1],0,0,0), C1,12, C0,14, 7); \
    if constexpr(VM==2){ \
      o[2]=__builtin_amdgcn_mfma_f32_32x32x16_bf16(PAF(0),VFR(0),o[2],0,0,0); C1[0]=EX(C1[0]-(NOMAX?0.f:mhat)); C1[1]=EX(C1[1]-(NOMAX?0.f:mhat)); PIN(C1); SBAR(); \
      o[3]=__builtin_amdgcn_mfma_f32_32x32x16_bf16(PAF(0),VFR(4),o[3],0,0,0); C1[2]=EX(C1[2]-(NOMAX?0.f:mhat)); C1[3]=EX(C1[3]-(NOMAX?0.f:mhat)); PIN(C1); SBAR(); \
      o[2]=__builtin_amdgcn_mfma_f32_32x32x16_bf16(PAF(1),VFR(1),o[2],0,0,0); C1[4]=EX(C1[4]-(NOMAX?0.f:mhat)); C1[5]=EX(C1[5]-(NOMAX?0.f:mhat)); PIN(C1); SBAR(); \
      o[3]=__builtin_amdgcn_mfma_f32_32x32x16_bf16(PAF(1),VFR(5),o[3],0,0,0); C1[6]=EX(C1[6]-(NOMAX?0.f:mhat)); C1[7]=EX(C1[7]-(NOMAX?0.f:mhat)); PIN(C1); SBAR(); \
      o[2]=__builtin_amdgcn_mfma_f32_32x32x16_bf16(PAF(2),VFR(2),o[2],0,0,0); C1[8]=EX(C1[8]-(NOMAX?0.f:mhat)); C1[9]=EX(C1[9]-(NOMAX?0.f:mhat)); PIN(C1); SBAR(); \
      o[3]=__builtin_amdgcn_mfma_f32_32x32x16_bf16(PAF(2),VFR(6),o[3],0,0,0); C1[10]=EX(C1[10]-(NOMAX?0.f:mhat)); C1[11]=EX(C1[11]-(NOMAX?0.f:mhat)); PIN(C1); SBAR(); \
      o[2]=__builtin_amdgcn_mfma_f32_32x32x16_bf16(PAF(3),VFR(3),o[2],0,0,0); C1[12]=EX(C1[12]-(NOMAX?0.f:mhat)); C1[13]=EX(C1[13]-(NOMAX?0.f:mhat)); PIN(C1); SBAR(); \
      o[3]=__builtin_amdgcn_mfma_f32_32x32x16_bf16(PAF(3),VFR(7),o[3],0,0,0); C1[14]=EX(C1[14]-(NOMAX?0.f:mhat)); C1[15]=EX(C1[15]-(NOMAX?0.f:mhat)); PIN(C1); SBAR(); SBAR(); } \
    }while(0)
  int t=1;
  for(;t+5<NT;t+=2){
    STEP(pB0,pB1,pA0,pA1,t,true,true,true);     if constexpr(VM==2){WAIT_BAR(3);}else{WAIT_BAR(2);} RESC(); ROT();
    STEP(pA0,pA1,pB0,pB1,t+1,true,true,true);   if constexpr(VM==2){WAIT_BAR(3);}else{WAIT_BAR(2);} RESC(); ROT();
  }
  #define ENDW(tt) do{ if((tt)+3<NT){ if constexpr(VM==2){WAIT_BAR(3);}else{WAIT_BAR(2);} } else if((tt)+2<NT){ if constexpr(VM==2){WAIT_BAR(2);}else{WAIT_BAR(1);} } else {WAIT_BAR(0);} }while(0)
  for(;t+1<NT;t+=2){
    STEP(pB0,pB1,pA0,pA1,t,(t+3<NT),(t+1<NT),(t+1<NT));       ENDW(t);   RESC(); ROT();
    STEP(pA0,pA1,pB0,pB1,t+1,(t+4<NT),(t+2<NT),(t+2<NT));     ENDW(t+1); RESC(); ROT();
  }
  STEP(pB0,pB1,pA0,pA1,NT-1,false,false,false); RESC();
  { float sacc=pB0[0]+pB0[1]; _Pragma("unroll") for(int r=2;r<16;++r)sacc+=pB0[r]; _Pragma("unroll") for(int r=0;r<16;++r)sacc+=pB1[r]; l_reg+=sacc;
    pw0=(u32x4){PKW(pB0,0),PKW(pB0,2),PKW(pB0,4),PKW(pB0,6)};pw1=(u32x4){PKW(pB0,8),PKW(pB0,10),PKW(pB0,12),PKW(pB0,14)};pw2=(u32x4){PKW(pB1,0),PKW(pB1,2),PKW(pB1,4),PKW(pB1,6)};pw3=(u32x4){PKW(pB1,8),PKW(pB1,10),PKW(pB1,12),PKW(pB1,14)};
    SBAR(); pv(o,vb0+VM*sl_cur,PAF(0),PAF(1),PAF(2),PAF(3)); if constexpr(VM==2) pv(o+2,vb0+VM*sl_cur+8192,PAF(0),PAF(1),PAF(2),PAF(3)); }
  #undef PKW
  #undef PAF
  #undef VFR
  #undef PIN
  #undef MX3
  #undef GAPA
  #undef GAPB
  #undef EX
  #undef VRD
  #undef KRD
  #undef STEP
  #undef ENDW
  {auto rr=__builtin_amdgcn_permlane32_swap(__float_as_uint(l_reg),__float_as_uint(l_reg),false,false);l_reg=__uint_as_float(rr[0])+__uint_as_float(rr[1]);}
  if(hi==0)wsf[32+r32]=l_reg;asm volatile("s_waitcnt lgkmcnt(0)":::"memory");
  float rli[16];
  #pragma unroll
  for(int r=0;r<16;++r)rli[r]=__builtin_amdgcn_rcpf(wsf[32+crow(r,hi)]);
  bf16*Ow=Ob+(long)(wid*QBLK)*QOP;
  bf16*stg=(bf16*)(shm+LDS_OST_)+wid*2048;
  if(sp<0){
    #pragma unroll
    for(int r=0;r<16;++r){const int orow=crow(r,hi);
      #pragma unroll
      for(int d0=0;d0<2;++d0)stg[orow*64+d0*32+r32]=__float2bfloat16(o[d0][r]*rli[r]);}
    asm volatile("s_waitcnt lgkmcnt(0)":::"memory");
    #pragma unroll
    for(int i=0;i<4;++i){const int row=i*8+(lane>>3),ch=lane&7; const u32x4 v=*(const u32x4*)(stg+row*64+ch*8); *(u32x4*)(Ow+(long)row*QOP+ch*8)=v;}
  } else {
    int lane_l=threadIdx.x&63; asm volatile("":"+v"(lane_l));
    float*sc=wscr+sp*2048+lane_l;
    #pragma unroll
    for(int d0=0;d0<2;++d0)
      #pragma unroll
      for(int r=0;r<16;++r)sc[(d0*16+r)*64]=o[d0][r]*rli[r];
    if constexpr(VM==2){ float*sc2=sc+4096;
      #pragma unroll
      for(int d0=0;d0<2;++d0)
        #pragma unroll
        for(int r=0;r<16;++r)sc2[(d0*16+r)*64]=o[2+d0][r]*rli[r]; }
  }
  __builtin_amdgcn_s_setprio(0);
  asm volatile("s_waitcnt vmcnt(0) lgkmcnt(0)\n\ts_barrier":::"memory");
  #undef DMA_K
  #undef DMA_V
  #undef START
  #undef RESC
  #undef ROT
}
__device__ __forceinline__ void b_combine(const float*wscr,const float lam,const float*gout,bf16*Ob,char*shm){
  int tid_=threadIdx.x; asm volatile("":"+v"(tid_));
  const int tid=tid_,lane=tid&63,r32=lane&31,hi=lane>>5; const int wid=__builtin_amdgcn_readfirstlane(tid>>6);
  f32x16 dl[2],dh[2];
  int lane_l=threadIdx.x&63; asm volatile("":"+v"(lane_l));
  #pragma unroll
  for(int d0=0;d0<2;++d0){
    const float*p0=wscr+lane_l+d0*1024; const float*p1=p0+2048; const float*p2=p0+4096; const float*p3=p0+6144;
    asm volatile("":"+v"(p0),"+v"(p1),"+v"(p2),"+v"(p3));
    #pragma unroll
    for(int r=0;r<16;++r){ dl[d0][r]=p0[r*64]-lam*p1[r*64]; }
    asm volatile("":::"memory");
    #pragma unroll
    for(int r=0;r<16;++r){ dh[d0][r]=p2[r*64]-lam*p3[r*64]; }
    asm volatile("":::"memory");
  }
  float rs[16];
  #pragma unroll
  for(int r=0;r<16;++r){ float s=dl[0][r]*dl[0][r]+dl[1][r]*dl[1][r]+dh[0][r]*dh[0][r]+dh[1][r]*dh[1][r];
    s+=__shfl_xor(s,1); s+=__shfl_xor(s,2); s+=__shfl_xor(s,4); s+=__shfl_xor(s,8); s+=__shfl_xor(s,16);
    rs[r]=(1.0f-LAM_INIT)/sqrtf(s*(1.0f/128.0f)+RMS_EPS); }
  const float g00=gout[r32],g01=gout[32+r32],g10=gout[64+r32],g11=gout[96+r32];
  bf16*Ow=Ob+(long)(wid*QBLK)*QOP;
  bf16*stg=(bf16*)(shm+LDS_OST)+wid*2048;
  #pragma unroll
  for(int r=0;r<16;++r){const int orow=crow(r,hi);
    stg[orow*64+r32]=__float2bfloat16(dl[0][r]*rs[r]*g00); stg[orow*64+32+r32]=__float2bfloat16(dl[1][r]*rs[r]*g01);}
  asm volatile("s_waitcnt lgkmcnt(0)":::"memory");
  #pragma unroll
  for(int i=0;i<4;++i){const int row=i*8+(lane>>3),ch=lane&7; const u32x4 v=*(const u32x4*)(stg+row*64+ch*8); *(u32x4*)(Ow+(long)row*QOP+ch*8)=v;}
  asm volatile("s_waitcnt lgkmcnt(0)":::"memory");
  #pragma unroll
  for(int r=0;r<16;++r){const int orow=crow(r,hi);
    stg[orow*64+r32]=__float2bfloat16(dh[0][r]*rs[r]*g10); stg[orow*64+32+r32]=__float2bfloat16(dh[1][r]*rs[r]*g11);}
  asm volatile("s_waitcnt lgkmcnt(0)":::"memory");
  #pragma unroll
  for(int i=0;i<4;++i){const int row=i*8+(lane>>3),ch=lane&7; const u32x4 v=*(const u32x4*)(stg+row*64+ch*8); *(u32x4*)(Ow+(long)row*QOP+64+ch*8)=v;}
  asm volatile("s_waitcnt vmcnt(0) lgkmcnt(0)\n\ts_barrier":::"memory");
}
constexpr int ATTN_LDS_BYTES=LDS_BYTES;
#undef SBAR
#undef WAIT_BAR
}

constexpr int NWAVES = 8;
constexpr size_t MiB = 1u << 20;
constexpr size_t WS_SSQ1 = 0, WS_SSQ2 = 0;
constexpr size_t WS_BAR = 3 * MiB, BAR_ZERO_BYTES = 16384;
constexpr size_t WS_W1GU = 6 * MiB;
constexpr size_t WS_W1D = 17 * MiB;
constexpr size_t WS_WIN = 22 * MiB + 512 * 1024;
constexpr size_t WS_WG = 27 * MiB;
constexpr size_t WS_WAB = 31 * MiB;
constexpr size_t WS_WOUT = 35 * MiB;
constexpr size_t WS_W2GU = 37 * MiB;
constexpr size_t WS_W2D = 48 * MiB;
constexpr size_t WS_ROPE = 53 * MiB + 512 * 1024;
constexpr size_t WS_RA = 56 * MiB;
constexpr size_t WS_RB = 152 * MiB;
constexpr size_t WS_RC = 248 * MiB;
constexpr size_t WS_ASCR = WS_RC + 120 * MiB;
constexpr size_t WS_END = 512 * MiB;
static_assert(WS_RC + (size_t)MROWS * DFF * 2 <= WS_END, "ws map");
constexpr int LDS_BYTES = 147456;

#define GAS __attribute__((address_space(1)))
#define LAS __attribute__((address_space(3)))
typedef unsigned short bf16;
typedef unsigned v4u __attribute__((ext_vector_type(4)));
typedef unsigned v2u __attribute__((ext_vector_type(2)));
typedef float f32x4 __attribute__((ext_vector_type(4)));
typedef float f32x2 __attribute__((ext_vector_type(2)));
#define LDS_WAIT() asm volatile("s_waitcnt lgkmcnt(0)" ::: "memory")
__device__ __forceinline__ unsigned pk2(float lo, float hi) { return pg8::cvt_pk_bf16(lo, hi); }
__device__ __forceinline__ float wave_sum(float v) {
#pragma unroll
    for (int o = 1; o < 64; o <<= 1) v += __shfl_xor(v, o);
    return v;
}

__device__ __forceinline__ int map_row(int mode, int n0) {
    switch (mode) {
        case 1: return 256 * (n0 >> 7) + (n0 & 127);
        case 2: return 256 * (n0 >> 7) + 128 + (n0 & 127);
        case 3:
            { const int x = (n0 < 512) ? n0 : (n0 < 768) ? n0 + 512 : (n0 < 1280) ? n0 - 256 : n0;
              return (x & ~255) + 128 * ((x >> 5) & 1) + 32 * ((x >> 6) & 3); }
        case 4: return n0 < 1024 ? 256 * (n0 >> 7) + (n0 & 127) : 256 * ((n0 - 1024) >> 7) + 128 + ((n0 - 1024) & 127);
        default: return n0;
    }
}
__device__ __forceinline__ void p0_transpose_item(const float* W, int K, int N, bf16* WT, int ldk, int kofs, int mode, LAS float* scr, int item, int lane) {
    const int nblk = N / 32, kb = item / nblk, nb = item % nblk, k0 = 64 * kb, n0 = 32 * nb;
#pragma unroll 8
    for (int i = 0; i < 32; ++i) { const int kk = 2 * i + (lane >> 5); scr[kk * 33 + (lane & 31)] = W[(size_t)(k0 + kk) * N + n0 + (lane & 31)]; }
    LDS_WAIT(); asm volatile("" ::: "memory");
    const int c = lane & 7; const int r0 = map_row(mode, n0);
#pragma unroll
    for (int j = 0; j < 4; ++j) { const int n = (lane >> 3) + 8 * j; const LAS float* s = scr + (8 * c) * 33 + n;
        v4u o; o.x = pk2(s[0 * 33], s[1 * 33]); o.y = pk2(s[2 * 33], s[3 * 33]); o.z = pk2(s[4 * 33], s[5 * 33]); o.w = pk2(s[6 * 33], s[7 * 33]);
        *(v4u*)(WT + (size_t)(r0 + n) * ldk + kofs + k0 + 8 * c) = o; }
    LDS_WAIT(); asm volatile("" ::: "memory");
}
__device__ __forceinline__ void sincos_d(double a, float& c, float& s) {
    const double q = rint(a * 0.63661977236758134308);
    double r = fma(-q, 1.57079632679489655800e+00, a); r = fma(-q, 6.12323399573676603587e-17, r);
    const int quad = (int)((long long)q & 3);
    const double r2 = r * r;
    const double sp = r * (1.0 + r2 * (-1.0 / 6.0 + r2 * (1.0 / 120.0 + r2 * (-1.0 / 5040.0 + r2 * (1.0 / 362880.0 + r2 * (-1.0 / 39916800.0 + r2 * (1.0 / 6227020800.0 + r2 * (-1.0 / 1307674368000.0))))))));
    const double cp = 1.0 + r2 * (-0.5 + r2 * (1.0 / 24.0 + r2 * (-1.0 / 720.0 + r2 * (1.0 / 40320.0 + r2 * (-1.0 / 3628800.0 + r2 * (1.0 / 479001600.0 + r2 * (-1.0 / 87178291200.0 + r2 * (1.0 / 20922789888000.0))))))));
    double ss, cc;
    if (quad == 0) { ss = sp; cc = cp; } else if (quad == 1) { ss = cp; cc = -sp; } else if (quad == 2) { ss = -sp; cc = -cp; } else { ss = -cp; cc = sp; }
    c = (float)cc; s = (float)ss;
}
__device__ __forceinline__ float inv_freq(int i) {
    switch (i) {
        case 0: return 1.000000000e+00f; case 1: return 5.623413324e-01f; case 2: return 3.162277639e-01f; case 3: return 1.778279394e-01f;
        case 4: return 1.000000015e-01f; case 5: return 5.623413250e-02f; case 6: return 3.162277490e-02f; case 7: return 1.778279431e-02f;
        case 8: return 9.999999776e-03f; case 9: return 5.623413250e-03f; case 10: return 3.162277630e-03f; case 11: return 1.778279431e-03f;
        case 12: return 1.000000047e-03f; case 13: return 5.623413017e-04f; case 14: return 3.162277571e-04f; case 15: return 1.778279402e-04f;
        case 16: return 1.000000000e+00f; case 17: return 1.939227432e-01f; case 18: return 3.760603070e-02f; case 19: return 7.292664610e-03f;
        case 20: return 1.414213562e-03f; case 21: return 2.742481884e-04f; case 22: return 5.318296098e-05f; default: return 1.031338616e-05f;
    }
}

#define XB_TMO      128
#define XB_XCNT(j)  (256  + 64 * (j))
#define XB_XSUB(j)  (1280 + 64 * (j))
#define XB_XGEN(j)  (2304 + 64 * (j))
#define XB_TOP      3328
#define XB_TOPGEN   3392
#define XCD_BAR_WORDS 3456
#define XB_SPIN_CAP (1u << 18)

__device__ __forceinline__ unsigned xb_ld(unsigned* p)              { return __hip_atomic_load(p, __ATOMIC_RELAXED, __HIP_MEMORY_SCOPE_AGENT); }
__device__ __forceinline__ unsigned xb_add(unsigned* p, unsigned v) { return __hip_atomic_fetch_add(p, v, __ATOMIC_RELAXED, __HIP_MEMORY_SCOPE_AGENT); }
__device__ __forceinline__ unsigned xb_xcc_id() { return (unsigned)__builtin_amdgcn_s_getreg((3 << 11) | 20) & 0xFu; }
#define XB_SPIN(cond, bar) do { unsigned _sp = 0; while (cond) { __builtin_amdgcn_s_sleep(1); \
    if ((++_sp & 255u) == 0u) { if (xb_ld(&(bar)[XB_TMO])) break; if (_sp > XB_SPIN_CAP) { atomicAdd(&(bar)[XB_TMO], 1u); break; } } } } while (0)

struct XcdBarrier {
    unsigned* bar; unsigned x;
    volatile LAS unsigned* st;
};

__device__ __forceinline__ XcdBarrier xcd_barrier_post(unsigned* bar, volatile LAS unsigned* st) {
    XcdBarrier b; b.bar = bar; b.x = xb_xcc_id(); b.st = st;
    if (threadIdx.x == 0) (void)xb_add(&bar[XB_XCNT(b.x)], 1u);
    return b;
}
__device__ __forceinline__ void xcd_barrier_complete(unsigned* bar, unsigned x, unsigned& nloc, unsigned& nx) {
    const unsigned G = gridDim.x * gridDim.y * gridDim.z;
    unsigned sum, cnt, mine, sp = 0u;
    for (;;) {
        sum = 0u; cnt = 0u; mine = 0u;
#pragma unroll
        for (unsigned j = 0; j < 16; ++j) { const unsigned c = xb_ld(&bar[XB_XCNT(j)]); sum += c; cnt += (c > 0u) ? 1u : 0u; mine = (j == x) ? c : mine; }
        if (sum == G) break;
        __builtin_amdgcn_s_sleep(1);
        if ((++sp & 255u) == 0u) { if (xb_ld(&bar[XB_TMO])) break; if (sp > XB_SPIN_CAP) { atomicAdd(&bar[XB_TMO], 1u); break; } }
    }
    nloc = mine > 0u ? mine : 1u; nx = cnt > 0u ? cnt : 1u;
}

__device__ __forceinline__ void xcd_barrier(const XcdBarrier& b) {
    asm volatile("s_waitcnt vmcnt(0)" ::: "memory");
    __syncthreads();
    if (threadIdx.x == 0) {
        unsigned* bar = b.bar;
        __builtin_amdgcn_s_waitcnt(0);
        unsigned nloc = b.st[0], nx = b.st[1];
        if (nloc == 0u) { xcd_barrier_complete(bar, b.x, nloc, nx); b.st[0] = nloc; b.st[1] = nx; }
        const unsigned old = xb_add(&bar[XB_XSUB(b.x)], 1u);
        const unsigned gen = old / nloc;
        if (old + 1u == (gen + 1u) * nloc) {
            __builtin_amdgcn_fence(__ATOMIC_RELEASE, "agent");
            asm volatile("s_waitcnt vmcnt(0)" ::: "memory");
            const unsigned og = xb_add(&bar[XB_TOP], 1u);
            const unsigned tg = og / nx;
            if (og + 1u == (tg + 1u) * nx) xb_add(&bar[XB_TOPGEN], 1u);
            else XB_SPIN(xb_ld(&bar[XB_TOPGEN]) == tg, bar);
            __builtin_amdgcn_fence(__ATOMIC_ACQUIRE, "agent");
            xb_add(&bar[XB_XGEN(b.x)], 1u);
            asm volatile("s_waitcnt vmcnt(0)" ::: "memory");
        } else {
            XB_SPIN(xb_ld(&bar[XB_XGEN(b.x)]) == gen, bar);
            __builtin_amdgcn_fence(__ATOMIC_ACQUIRE, "agent");
            asm volatile("s_waitcnt vmcnt(0)" ::: "memory");
        }
    }
    __syncthreads();
}

struct Args { const float* in[25]; float* out_; unsigned char* ws_; };

#define ATT_UNITS(NM_) do { \
        for (int i = vcu; i < 256; i += G) { const int seq = i >> 7, head = (i >> 5) & 3, qb = i & 31; const long rb = (long)seq * 8192; \
            for (int sp = 0; sp < 2; ++sp) { const int jm = sp, vh = 0; \
                attn_body::attn_unit<8, 2, NM_>(QOa + (rb + qb * 256) * QOP + 512 + head * 128 + jm * 64, KVa + rb * KVP + 256 + head * 128 + jm * 64, KVa + rb * KVP + 768 + head * 128 + vh * 64, \
                                        (attn_body::bf16*)QO + (rb + qb * 256) * QOP + 512 + head * 128, 128, sp, wscr, shm); } \
            attn_body::b_combine(wscr, lam, gout, (attn_body::bf16*)QO + (rb + qb * 256) * QOP + 512 + head * 128, shm); } \
        for (int i = vcu; i < 512; i += G) { const int seq = i >> 6, head = (i >> 4) & 3, qb = i & 15; const long rb = (long)M_P + (long)seq * 4096; \
            for (int sp = 0; sp < 2; ++sp) { const int jm = sp, vh = 0; \
                attn_body::attn_unit<8, 2, NM_>(QOa + (rb + qb * 256) * QOP + 512 + head * 128 + jm * 64, KVa + rb * KVP + 256 + head * 128 + jm * 64, KVa + rb * KVP + 768 + head * 128 + vh * 64, \
                                        (attn_body::bf16*)QO + (rb + qb * 256) * QOP + 512 + head * 128, 64, sp, wscr, shm); } \
            attn_body::b_combine(wscr, lam, gout, (attn_body::bf16*)QO + (rb + qb * 256) * QOP + 512 + head * 128, shm); } \
        for (int i = vcu; i < 512; i += G) { const int seq = i >> 8, head = (i >> 5) & 7, qb = i & 31; const long rb = (long)seq * 8192; \
            attn_body::attn_unit<8, 1, NM_>(QOa + (rb + qb * 256) * QOP + head * 64, KVa + rb * KVP + (head >> 2) * 64, KVa + rb * KVP + 128 + (head >> 2) * 64, \
                                    (attn_body::bf16*)QO + (rb + qb * 256) * QOP + head * 64, 128, -1, wscr, shm); } \
        for (int i = vcu; i < 1024; i += G) { const int seq = i >> 7, head = (i >> 4) & 7, qb = i & 15; const long rb = (long)M_P + (long)seq * 4096; \
            attn_body::attn_unit<8, 1, NM_>(QOa + (rb + qb * 256) * QOP + head * 64, KVa + rb * KVP + (head >> 2) * 64, KVa + rb * KVP + 128 + (head >> 2) * 64, \
                                    (attn_body::bf16*)QO + (rb + qb * 256) * QOP + head * 64, 64, -1, wscr, shm); } \
        } while (0)
__global__ void __launch_bounds__(NWAVES * 64, 2) mk_fwd(Args args) {
    extern __shared__ __attribute__((aligned(16))) unsigned char lds[];
    cg::grid_group grid = cg::this_grid();
    LAS unsigned char* ldsl = (LAS unsigned char*)lds;
    if (threadIdx.x < 2) ((volatile LAS unsigned*)(ldsl + 131072))[threadIdx.x] = 0u;
    __syncthreads();
    if (args.ws_ == nullptr) { grid.sync(); }
    const XcdBarrier xbar = xcd_barrier_post((unsigned*)(args.ws_ + WS_BAR), (volatile LAS unsigned*)(ldsl + 131072));
#define GRID_SYNC() do { asm volatile("s_waitcnt vmcnt(0) lgkmcnt(0)" ::: "memory"); grid.sync(); __builtin_amdgcn_fence(__ATOMIC_ACQUIRE, "agent"); asm volatile("s_waitcnt vmcnt(0)" ::: "memory"); } while (0)
#define XSYNC() xcd_barrier(xbar)
#define PHASE_IDS() int tid = threadIdx.x; asm volatile("" : "+v"(tid)); const int lane = tid & 63, wave = __builtin_amdgcn_readfirstlane(tid >> 6); const int gw = vcu * NWAVES + wave, NGW = G * NWAVES; (void)lane; (void)gw; (void)NGW
    const int G = gridDim.x; const int bx = blockIdx.x; const int vcu = (G % 8 == 0) ? (bx % 8) * (G / 8) + bx / 8 : bx;
#define ws (args.ws_)
#define xp (args.in[0])
#define xs (args.in[1])
#define out (args.out_)
#define ssq1 ((float*)(args.ws_ + WS_SSQ1))
#define ssq2 ((float*)(args.ws_ + WS_SSQ2))
#define rope ((f32x2*)(args.ws_ + WS_ROPE))
#define W1GU ((bf16*)(args.ws_ + WS_W1GU))
#define W1D ((bf16*)(args.ws_ + WS_W1D))
#define WIN ((bf16*)(args.ws_ + WS_WIN))
#define WG ((bf16*)(args.ws_ + WS_WG))
#define WAB ((bf16*)(args.ws_ + WS_WAB))
#define WOUT ((bf16*)(args.ws_ + WS_WOUT))
#define W2GU ((bf16*)(args.ws_ + WS_W2GU))
#define W2D ((bf16*)(args.ws_ + WS_W2D))
#define XN ((bf16*)(args.ws_ + WS_RA))
#define TB ((bf16*)(args.ws_ + WS_RA))
#define QO ((bf16*)(args.ws_ + WS_RB))
#define XN3 ((bf16*)(args.ws_ + WS_RB))
#define HB ((bf16*)(args.ws_ + WS_RC))
#define KV ((bf16*)(args.ws_ + WS_RC))
#define GB ((bf16*)(args.ws_ + WS_RC))

    {
        PHASE_IDS();
        LAS float* scr = (LAS float*)(ldsl + wave * 16384);
        constexpr int I_GU = (DM / 64) * (DFF / 32), I_D = (DFF / 64) * (DM / 32), I_IN = (DM / 64) * (2304 / 32), I_G = (DM / 64) * (2048 / 32), I_OA = (512 / 64) * (DM / 32), I_OUT = (DM / 64) * (DM / 32);
        constexpr int NITEMS = 2 * (2 * I_GU + I_D) + I_IN + I_G + 2 * I_OA + I_OUT;
        for (int it = gw; it < NITEMS; it += NGW) {
            int r = it;
            if (r < I_GU) { p0_transpose_item(args.in[3], DM, DFF, W1GU, DM, 0, 1, scr, r, lane); continue; } r -= I_GU;
            if (r < I_GU) { p0_transpose_item(args.in[4], DM, DFF, W1GU, DM, 0, 2, scr, r, lane); continue; } r -= I_GU;
            if (r < I_D) { p0_transpose_item(args.in[5], DFF, DM, W1D, DFF, 0, 0, scr, r, lane); continue; } r -= I_D;
            if (r < I_GU) { p0_transpose_item(args.in[22], DM, DFF, W2GU, DM, 0, 1, scr, r, lane); continue; } r -= I_GU;
            if (r < I_GU) { p0_transpose_item(args.in[23], DM, DFF, W2GU, DM, 0, 2, scr, r, lane); continue; } r -= I_GU;
            if (r < I_D) { p0_transpose_item(args.in[24], DFF, DM, W2D, DFF, 0, 0, scr, r, lane); continue; } r -= I_D;
            if (r < I_IN) { p0_transpose_item(args.in[7], DM, 2304, WIN, DM, 0, 3, scr, r, lane); continue; } r -= I_IN;
            if (r < I_G) { p0_transpose_item(args.in[8], DM, 2048, WG, DM, 0, 4, scr, r, lane); continue; } r -= I_G;
            if (r < I_OA) { p0_transpose_item(args.in[18], 512, DM, WAB, DM, 0, 1, scr, r, lane); continue; } r -= I_OA;
            if (r < I_OA) { p0_transpose_item(args.in[19], 512, DM, WAB, DM, 512, 2, scr, r, lane); continue; } r -= I_OA;
            p0_transpose_item(args.in[20], DM, DM, WOUT, DM, 0, 0, scr, r, lane);
        }
        for (int idx = bx * 512 + tid; idx < 2048 * 64; idx += G * 512) { const int row = idx >> 6, ch = idx & 63; const int k0 = (((row & 255) < 128) ? 512 : 0) + ch * 8;
            *(v4u*)(WAB + (size_t)row * DM + k0) = (v4u){0u, 0u, 0u, 0u}; }
        for (int idx = bx * 512 + tid; idx < 8192 * 40; idx += G * 512) { const int t = idx / 40, i = idx % 40;
            float ang; if (i < 16) ang = (float)(t >> 6) * inv_freq(i); else if (i < 32) ang = (float)(t & 63) * inv_freq(i - 16); else ang = (float)t * inv_freq(16 + (i - 32));
            float c, s; sincos_d((double)ang, c, s); rope[idx] = (f32x2){c, s}; }
        const float* g1 = args.in[2]; f32x4 gv[4];
#pragma unroll
        for (int j = 0; j < 4; ++j) gv[j] = *((const f32x4*)g1 + lane + 64 * j);
        for (int m = gw; m < MROWS; m += NGW) {
            const float* xr = (m < M_P) ? xp + (size_t)m * DM : xs + (size_t)(m - M_P) * DM;
            f32x4 v[4]; float s = 0.f;
#pragma unroll
            for (int j = 0; j < 4; ++j) { v[j] = *((const f32x4*)xr + lane + 64 * j); s += (v[j].x * v[j].x + v[j].y * v[j].y) + (v[j].z * v[j].z + v[j].w * v[j].w); }
            const float rs = 1.0f / sqrtf(wave_sum(s) * (1.0f / DM) + RMS_EPS);
            v2u* o8 = (v2u*)(XN + (size_t)m * DM) + lane;
#pragma unroll
            for (int j = 0; j < 4; ++j) { const f32x4 y = v[j] * rs * gv[j]; o8[64 * j] = (v2u){pk2(y.x, y.y), pk2(y.z, y.w)}; }
        }
    }
    XSYNC();

    {
        pg8::Gemm g{XN, W1GU, MROWS, 2 * DFF, DM, DM}; pg8::StaticOrder S; S.init(MROWS, 2 * DFF, G, bx);
        pg8::EpiSwiGLU E{HB, nullptr};
        pg8::gemm_phase<pg8::EpiSwiGLU>(ldsl, g, S, E);
    }
    XSYNC();
    {
        pg8::Gemm g{HB, W1D, MROWS, DM, DFF, DFF}; pg8::StaticOrder S; S.init(MROWS, DM, G, bx);
        pg8::EpiRes<1, true> E{xp, xs, out, XN, args.in[6], ssq1};
        pg8::gemm_phase<pg8::EpiRes<1, true>>(ldsl, g, S, E);
    }
    XSYNC();
    {
        pg8::Gemm g{XN, WIN, MROWS, 2304, DM, DM}; pg8::StaticOrder S; S.init(MROWS, 2304, G, bx);
        pg8::EpiInProjPrep E{QO, KV, ssq1, (const float*)rope, args.in[9], args.in[10], args.in[11], args.in[12]};
        pg8::gemm_phase<pg8::EpiInProjPrep>(ldsl, g, S, E);
    }
    XSYNC();
    {
        PHASE_IDS();
        float lam;
        { const float a = args.in[13][lane] * args.in[14][lane], b = args.in[15][lane] * args.in[16][lane];
          lam = expf(wave_sum(a)) - expf(wave_sum(b)) + LAM_INIT; }
        float* wscr = (float*)(ws + WS_ASCR) + ((size_t)bx * NWAVES + wave) * 8192;
        const attn_body::bf16* QOa = (const attn_body::bf16*)QO; const attn_body::bf16* KVa = (const attn_body::bf16*)KV;
        const float* gout = args.in[17];
        char* shm = (char*)lds;
        bool nomax; {
          float ga = fabsf(args.in[9][lane]), gk = fabsf(args.in[10][lane]), gb = fabsf(args.in[11][lane]), gl = fabsf(args.in[12][lane]);
#pragma unroll
          for (int o_ = 1; o_ < 64; o_ <<= 1) { ga = fmaxf(ga, __shfl_xor(ga, o_)); gk = fmaxf(gk, __shfl_xor(gk, o_)); gb = fmaxf(gb, __shfl_xor(gb, o_)); gl = fmaxf(gl, __shfl_xor(gl, o_)); }
          const float bnd = 64.0f * attn_body::C2 * fmaxf(ga * gk, gb * gl) * 1.02f;
          nomax = __builtin_amdgcn_readfirstlane((int)(bnd <= 40.0f)) != 0; }
        if (nomax) { ATT_UNITS(true); } else { ATT_UNITS(false); }
    }
    XSYNC();
    {
        pg8::Gemm g{XN, WG, MROWS, 2048, DM, DM}; pg8::StaticOrder S; S.init(MROWS, 2048, G, bx);
        pg8::EpiGate E{GB, ssq1};
        pg8::gemm_phase<pg8::EpiGate>(ldsl, g, S, E);
    }
    {
        pg8::Gemm g{QO, WAB, MROWS, 2048, DM, QOP}; pg8::StaticOrder S; S.init(MROWS, 2048, G, bx);
        pg8::EpiMerge E{GB, GB};
        pg8::gemm_phase<pg8::EpiMerge, true, true>(ldsl, g, S, E);
    }
    XSYNC();
    {
        pg8::Gemm g{GB, WOUT, MROWS, DM, DM, 2048, 512}; pg8::StaticOrder S; S.init(MROWS, DM, G, bx);
        pg8::EpiRes<2, true> E{out, out + (size_t)M_P * DM, out, XN3, args.in[21], ssq2};
        pg8::gemm_phase<pg8::EpiRes<2, true>>(ldsl, g, S, E);
    }
    XSYNC();
    {
        pg8::Gemm g{XN3, W2GU, MROWS, 2 * DFF, DM, DM}; pg8::StaticOrder S; S.init(MROWS, 2 * DFF, G, bx);
        pg8::EpiSwiGLU E{HB, ssq2};
        pg8::gemm_phase<pg8::EpiSwiGLU>(ldsl, g, S, E);
    }
    XSYNC();
    {
        pg8::Gemm g{HB, W2D, MROWS, DM, DFF, DFF}; pg8::StaticOrder S; S.init(MROWS, DM, G, bx);
        pg8::EpiRes<1, false> E{out, out + (size_t)M_P * DM, out, nullptr, nullptr, nullptr};
        pg8::gemm_phase<pg8::EpiRes<1, false>>(ldsl, g, S, E);
    }
#undef ws
#undef xp
#undef xs
#undef out
#undef ssq1
#undef ssq2
#undef rope
#undef W1GU
#undef W1D
#undef WIN
#undef WG
#undef WAB
#undef WOUT
#undef W2GU
#undef W2D
#undef XN
#undef TB
#undef QO
#undef XN3
#undef HB
#undef KV
#undef GB
}

extern "C" void kernel_launch(void* const* d_in, const int* in_sizes, int n_in, void* d_out, int out_size, void* d_ws, size_t ws_size, hipStream_t stream) {
    static int grid = 0;
    if (grid == 0) {
        if (n_in != 25 || out_size != MROWS * DM || ws_size < WS_END) { fprintf(stderr, "kernel_launch: unexpected shapes (n_in %d, out %d, ws %zu)\n", n_in, out_size, ws_size); grid = -1; return; }
        int dev = 0, cus = 0, per_cu = 0;
        if (hipGetDevice(&dev) != hipSuccess || hipDeviceGetAttribute(&cus, hipDeviceAttributeMultiprocessorCount, dev) != hipSuccess) { grid = -1; return; }
        if (hipFuncSetAttribute((const void*)mk_fwd, hipFuncAttributeMaxDynamicSharedMemorySize, LDS_BYTES) != hipSuccess) { fprintf(stderr, "kernel_launch: hipFuncSetAttribute failed\n"); grid = -1; return; }
        if (hipOccupancyMaxActiveBlocksPerMultiprocessor(&per_cu, (const void*)mk_fwd, NWAVES * 64, LDS_BYTES) != hipSuccess || per_cu < 1) { fprintf(stderr, "kernel_launch: occupancy query says %d\n", per_cu); per_cu = 1; }
        (void)hipGetLastError();
        grid = cus;
    }
    if (grid < 0) return;
    (void)hipMemsetAsync((char*)d_ws + WS_BAR, 0, BAR_ZERO_BYTES, stream);
    Args a{};
    for (int i = 0; i < 25; ++i) a.in[i] = (const float*)d_in[i];
    a.out_ = (float*)d_out; a.ws_ = (unsigned char*)d_ws;
    void* kargs[] = {&a};
    hipError_t e = hipLaunchCooperativeKernel((const void*)mk_fwd, dim3(grid), dim3(NWAVES * 64), kargs, LDS_BYTES, stream);
    if (e != hipSuccess) fprintf(stderr, "kernel_launch: cooperative launch failed: %s (grid %d)\n", hipGetErrorString(e), grid);
}
```
